# Optimizing an MI355X kernel written in HIP

```python
import jax, jax.numpy as jnp
from jax import lax
import numpy as np

D_MODEL = 4096
BATCH = 4
SEQ = 2048
DEPTH = 4

N_A_LAYERS = DEPTH // 2
N_B_LAYERS = DEPTH - N_A_LAYERS
D_FF = 6144
ROPE_THETA = 10000.0
EPS = 1e-6
NEG = -1e30
FORCE = 1e6
Q_BLOCK = 128

MLA_HEADS = 32
MLA_Q_LORA = 1024
MLA_KV_LORA = 512
MLA_NOPE = 128
MLA_ROPE = 64
MLA_V = 128
MLA_QK = MLA_NOPE + MLA_ROPE
MLA_IN = MLA_Q_LORA + MLA_KV_LORA + MLA_ROPE

NSA_HEADS = 32
NSA_GROUPS = 4
NSA_HPG = NSA_HEADS // NSA_GROUPS
NSA_DH = 128
N_BRANCH = 3
N_KV_PARTS = 2 * N_BRANCH
CMP_BLOCK = 32
CMP_STRIDE = 16
CMP_HIDDEN = 256
SLC_BLOCK = 64
SLC_TOPK = 16
SLC_Q_BLOCK = 32
WINDOW = 512
NSA_Q_WIDTH = NSA_HEADS * NSA_DH
NSA_IN = NSA_Q_WIDTH + N_BRANCH * NSA_HEADS

kernel_name = "yoco_mla_nsa_macaron_trunk"


def rms_norm(x, g):
    xf = x.astype(jnp.float32)
    y = xf * lax.rsqrt(jnp.mean(xf * xf, axis=-1, keepdims=True) + EPS)
    return (y * g.astype(jnp.float32)).astype(x.dtype)


def rope_cos_sin(positions, dim):
    inv = jnp.power(ROPE_THETA, -jnp.arange(0, dim, 2, dtype=jnp.float32) / dim)
    ang = positions.astype(jnp.float32)[..., None] * inv
    return jnp.cos(ang), jnp.sin(ang)


def apply_rope(x, cos, sin):
    nmid = x.ndim - 3
    shp = cos.shape[:2] + (1,) * nmid + cos.shape[-1:]
    c = cos.reshape(shp)
    s = sin.reshape(shp)
    x1, x2 = jnp.split(x.astype(jnp.float32), 2, axis=-1)
    return jnp.concatenate([x1 * c - x2 * s, x2 * c + x1 * s], axis=-1).astype(x.dtype)


def swiglu(x, wg, wu, wd):
    return (jax.nn.silu(x @ wg) * (x @ wu)) @ wd


def causal_dense_attention(q, k, v):
    B, S, H, Dq = q.shape
    nb = S // Q_BLOCK
    scale = Dq ** -0.5
    qb = q.reshape(B, nb, Q_BLOCK, H, Dq).transpose(1, 0, 2, 3, 4)
    kpos = jnp.arange(S)

    def one(args):
        qi, i = args
        s = jnp.einsum('bqhd,bkhd->bhqk', qi, k).astype(jnp.float32) * scale
        qpos = i * Q_BLOCK + jnp.arange(Q_BLOCK)
        mask = kpos[None, :] <= qpos[:, None]
        p = jax.nn.softmax(jnp.where(mask, s, NEG), axis=-1)
        return jnp.einsum('bhqk,bkhd->bqhd', p.astype(v.dtype), v)

    o = lax.map(one, (qb, jnp.arange(nb)))
    return o.transpose(1, 0, 2, 3, 4).reshape(B, S, H, v.shape[-1])


def mla_mixer(u, cos, sin, w_in, g_cq, g_ckv, w_uq, w_ukv, g_q, g_k, w_o):
    B, S, _ = u.shape
    c = u @ w_in
    cq, ckv, k_rope = jnp.split(c, [MLA_Q_LORA, MLA_Q_LORA + MLA_KV_LORA], axis=-1)
    q = (rms_norm(cq, g_cq) @ w_uq).reshape(B, S, MLA_HEADS, MLA_QK)
    kv = (rms_norm(ckv, g_ckv) @ w_ukv).reshape(B, S, MLA_HEADS, MLA_NOPE + MLA_V)
    k_nope, v = jnp.split(kv, [MLA_NOPE], axis=-1)
    k = jnp.concatenate([k_nope, jnp.broadcast_to(k_rope[:, :, None, :], (B, S, MLA_HEADS, MLA_ROPE))], axis=-1)
    q = rms_norm(q, g_q)
    k = rms_norm(k, g_k)
    q = jnp.concatenate([q[..., :MLA_NOPE], apply_rope(q[..., MLA_NOPE:], cos, sin)], axis=-1)
    k = jnp.concatenate([k[..., :MLA_NOPE], apply_rope(k[..., MLA_NOPE:], cos, sin)], axis=-1)
    o = causal_dense_attention(q, k, v)
    return o.reshape(B, S, MLA_HEADS * MLA_V) @ w_o


def nsa_shared_kv(h, cos, sin, kv_norm, kv_w, cmp_pos_k, cmp_pos_v, cmp_k_w1, cmp_k_b1, cmp_k_w2,
                  cmp_v_w1, cmp_v_b1, cmp_v_w2, g_k_cmp, g_k_slc, g_k_win):
    B, S, _ = h.shape
    y = rms_norm(h, kv_norm)
    kv = (y @ kv_w).reshape(B, S, N_KV_PARTS, NSA_GROUPS, NSA_DH)
    k_cmp_raw, v_cmp_raw, k_slc, v_slc, k_win, v_win = [kv[:, :, i] for i in range(N_KV_PARTS)]
    n_cmp = (S - CMP_BLOCK) // CMP_STRIDE + 1
    idx = np.arange(n_cmp)[:, None] * CMP_STRIDE + np.arange(CMP_BLOCK)[None, :]

    def compress(t, pos, w1, b1, w2):
        blk = t[:, idx] + pos[None, None, :, None, :]
        blk = blk.transpose(0, 1, 3, 2, 4).reshape(B, n_cmp, NSA_GROUPS, CMP_BLOCK * NSA_DH)
        return jax.nn.silu(blk @ w1 + b1) @ w2

    k_cmp = rms_norm(compress(k_cmp_raw, cmp_pos_k, cmp_k_w1, cmp_k_b1, cmp_k_w2), g_k_cmp)
    v_cmp = compress(v_cmp_raw, cmp_pos_v, cmp_v_w1, cmp_v_b1, cmp_v_w2)
    k_slc = apply_rope(rms_norm(k_slc, g_k_slc), cos, sin)
    k_win = apply_rope(rms_norm(k_win, g_k_win), cos, sin)
    return (k_cmp, v_cmp, k_slc, v_slc, k_win, v_win)


def cmp_to_slc_weights(n_cmp, n_slc):
    cs = np.arange(n_cmp)[:, None] * CMP_STRIDE
    ss = np.arange(n_slc)[None, :] * SLC_BLOCK
    ov = np.clip(np.minimum(cs + CMP_BLOCK, ss + SLC_BLOCK) - np.maximum(cs, ss), 0, None)
    return (ov / CMP_STRIDE).astype(np.float32)


def selected_attention(q, k, v, sel):
    B, S, G, HPG, DH = q.shape
    n_slc = S // SLC_BLOCK
    n_sel = sel.shape[-1]
    scale = DH ** -0.5
    kb = k.reshape(B, n_slc, SLC_BLOCK, G, DH).transpose(0, 3, 1, 2, 4)
    vb = v.reshape(B, n_slc, SLC_BLOCK, G, DH).transpose(0, 3, 1, 2, 4)
    nq = S // SLC_Q_BLOCK
    qb = q.reshape(B, nq, SLC_Q_BLOCK, G, HPG, DH).transpose(1, 0, 2, 3, 4, 5)
    selb = sel.reshape(B, G, nq, SLC_Q_BLOCK, n_sel).transpose(2, 0, 1, 3, 4)
    bi = jnp.arange(B)[:, None, None, None]
    gi = jnp.arange(G)[None, :, None, None]

    def one(args):
        qi, si, i = args
        kg = kb[bi, gi, si]
        vg = vb[bi, gi, si]
        s = jnp.einsum('bqghd,bgqnld->bghqnl', qi, kg).astype(jnp.float32) * scale
        qpos = i * SLC_Q_BLOCK + jnp.arange(SLC_Q_BLOCK)
        kpos = si[..., None] * SLC_BLOCK + jnp.arange(SLC_BLOCK)
        mask = (kpos <= qpos[None, None, :, None, None])[:, :, None]
        s = jnp.where(mask, s, NEG).reshape(B, G, HPG, SLC_Q_BLOCK, n_sel * SLC_BLOCK)
        p = jax.nn.softmax(s, axis=-1).reshape(B, G, HPG, SLC_Q_BLOCK, n_sel, SLC_BLOCK)
        return jnp.einsum('bghqnl,bgqnld->bqghd', p.astype(vg.dtype), vg)

    o = lax.map(one, (qb, selb, jnp.arange(nq)))
    return o.transpose(1, 0, 2, 3, 4, 5).reshape(B, S, G, HPG, DH)


def window_attention(q, k, v):
    B, S, G, HPG, DH = q.shape
    nb = S // Q_BLOCK
    span = Q_BLOCK + WINDOW
    scale = DH ** -0.5
    kp = jnp.pad(k, ((0, 0), (WINDOW, 0), (0, 0), (0, 0)))
    vp = jnp.pad(v, ((0, 0), (WINDOW, 0), (0, 0), (0, 0)))
    qb = q.reshape(B, nb, Q_BLOCK, G, HPG, DH).transpose(1, 0, 2, 3, 4, 5)

    def one(args):
        qi, i = args
        start = i * Q_BLOCK
        ki = lax.dynamic_slice_in_dim(kp, start, span, axis=1)
        vi = lax.dynamic_slice_in_dim(vp, start, span, axis=1)
        s = jnp.einsum('bqghd,bkgd->bghqk', qi, ki).astype(jnp.float32) * scale
        qpos = start + jnp.arange(Q_BLOCK)
        kpos = start - WINDOW + jnp.arange(span)
        diff = qpos[:, None] - kpos[None, :]
        mask = (diff >= 0) & (diff < WINDOW) & (kpos[None, :] >= 0)
        p = jax.nn.softmax(jnp.where(mask, s, NEG), axis=-1)
        return jnp.einsum('bghqk,bkgd->bqghd', p.astype(vi.dtype), vi)

    o = lax.map(one, (qb, jnp.arange(nb)))
    return o.transpose(1, 0, 2, 3, 4, 5).reshape(B, S, G, HPG, DH)


def nsa_mixer(u, cos, sin, shared, w_in, b_gate, g_q, w_o):
    k_cmp, v_cmp, k_slc, v_slc, k_win, v_win = shared
    B, S, _ = u.shape
    proj = u @ w_in
    q = proj[..., :NSA_Q_WIDTH].reshape(B, S, NSA_GROUPS, NSA_HPG, NSA_DH)
    gates = jax.nn.sigmoid(proj[..., NSA_Q_WIDTH:] + b_gate).reshape(B, S, NSA_GROUPS, NSA_HPG, N_BRANCH)
    q = rms_norm(q, g_q)
    q_rot = apply_rope(q, cos, sin)
    scale = NSA_DH ** -0.5
    spos = jnp.arange(S)
    n_cmp = k_cmp.shape[1]
    cmp_end = jnp.arange(n_cmp) * CMP_STRIDE + CMP_BLOCK - 1
    cmask = cmp_end[None, :] <= spos[:, None]
    sc = jnp.einsum('bsghd,bngd->bghsn', q, k_cmp).astype(jnp.float32) * scale
    p_cmp = jax.nn.softmax(jnp.where(cmask, sc, NEG), axis=-1) * cmask
    o_cmp = jnp.einsum('bghsn,bngd->bsghd', p_cmp.astype(v_cmp.dtype), v_cmp)
    n_slc = S // SLC_BLOCK
    n_sel = min(SLC_TOPK, n_slc)
    agg = jnp.asarray(cmp_to_slc_weights(n_cmp, n_slc))
    imp = jnp.einsum('bghsn,nj->bgsj', p_cmp, agg)
    jb = jnp.arange(n_slc)
    cur = spos // SLC_BLOCK
    valid = (jb[None, :] * SLC_BLOCK) <= spos[:, None]
    forced = (jb[None, :] == 0) | (jb[None, :] == cur[:, None]) | (jb[None, :] == cur[:, None] - 1)
    imp = jnp.where(forced, FORCE, jnp.where(valid, imp, -1.0))
    _, sel = lax.top_k(imp, n_sel)
    o_slc = selected_attention(q_rot, k_slc, v_slc, sel)
    o_win = window_attention(q_rot, k_win, v_win)
    o = gates[..., 0:1] * o_cmp + gates[..., 1:2] * o_slc + gates[..., 2:3] * o_win
    return o.reshape(B, S, NSA_Q_WIDTH) @ w_o


def setup_inputs(seed: int = 0) -> dict:
    key = jax.random.key(seed)
    ks = iter(jax.random.split(key, 64))

    def w(shape, fan_in):
        return jax.random.normal(next(ks), shape, jnp.float32) * (fan_in ** -0.5)

    def gain(shape):
        return 1.0 + 0.02 * jax.random.normal(next(ks), shape, jnp.float32)

    def small(shape, s=0.02):
        return s * jax.random.normal(next(ks), shape, jnp.float32)

    D, F = D_MODEL, D_FF
    return {
        'x': jax.random.normal(next(ks), (BATCH, SEQ, D), jnp.float32),
        'positions': jnp.broadcast_to(jnp.arange(SEQ, dtype=jnp.int32), (BATCH, SEQ)),
        'ffn1_norm': gain((DEPTH, D)),
        'ffn1_w_gate': w((DEPTH, D, F), D),
        'ffn1_w_up': w((DEPTH, D, F), D),
        'ffn1_w_down': w((DEPTH, F, D), F),
        'mix_norm': gain((DEPTH, D)),
        'ffn2_norm': gain((DEPTH, D)),
        'ffn2_w_gate': w((DEPTH, D, F), D),
        'ffn2_w_up': w((DEPTH, D, F), D),
        'ffn2_w_down': w((DEPTH, F, D), F),
        'mla_w_in': w((N_A_LAYERS, D, MLA_IN), D),
        'mla_g_cq': gain((N_A_LAYERS, MLA_Q_LORA)),
        'mla_g_ckv': gain((N_A_LAYERS, MLA_KV_LORA)),
        'mla_w_uq': w((N_A_LAYERS, MLA_Q_LORA, MLA_HEADS * MLA_QK), MLA_Q_LORA),
        'mla_w_ukv': w((N_A_LAYERS, MLA_KV_LORA, MLA_HEADS * (MLA_NOPE + MLA_V)), MLA_KV_LORA),
        'mla_g_q': gain((N_A_LAYERS, MLA_QK)),
        'mla_g_k': gain((N_A_LAYERS, MLA_QK)),
        'mla_w_o': w((N_A_LAYERS, MLA_HEADS * MLA_V, D), MLA_HEADS * MLA_V),
        'kv_norm': gain((D,)),
        'kv_w': w((D, N_KV_PARTS * NSA_GROUPS * NSA_DH), D),
        'cmp_pos_k': small((CMP_BLOCK, NSA_DH), 0.1),
        'cmp_pos_v': small((CMP_BLOCK, NSA_DH), 0.1),
        'cmp_k_w1': w((CMP_BLOCK * NSA_DH, CMP_HIDDEN), CMP_BLOCK * NSA_DH),
        'cmp_k_b1': small((CMP_HIDDEN,)),
        'cmp_k_w2': w((CMP_HIDDEN, NSA_DH), CMP_HIDDEN),
        'cmp_v_w1': w((CMP_BLOCK * NSA_DH, CMP_HIDDEN), CMP_BLOCK * NSA_DH),
        'cmp_v_b1': small((CMP_HIDDEN,)),
        'cmp_v_w2': w((CMP_HIDDEN, NSA_DH), CMP_HIDDEN),
        'g_k_cmp': gain((NSA_DH,)),
        'g_k_slc': gain((NSA_DH,)),
        'g_k_win': gain((NSA_DH,)),
        'nsa_w_in': w((N_B_LAYERS, D, NSA_IN), D),
        'nsa_b_gate': small((N_B_LAYERS, N_BRANCH * NSA_HEADS)),
        'nsa_g_q': gain((N_B_LAYERS, NSA_DH)),
        'nsa_w_o': w((N_B_LAYERS, NSA_Q_WIDTH, D), NSA_Q_WIDTH),
    }


def reference(x, positions, ffn1_norm, ffn1_w_gate, ffn1_w_up, ffn1_w_down, mix_norm, ffn2_norm,
              ffn2_w_gate, ffn2_w_up, ffn2_w_down, mla_w_in, mla_g_cq, mla_g_ckv, mla_w_uq, mla_w_ukv,
              mla_g_q, mla_g_k, mla_w_o, kv_norm, kv_w, cmp_pos_k, cmp_pos_v, cmp_k_w1, cmp_k_b1,
              cmp_k_w2, cmp_v_w1, cmp_v_b1, cmp_v_w2, g_k_cmp, g_k_slc, g_k_win, nsa_w_in, nsa_b_gate,
              nsa_g_q, nsa_w_o):
    cos_a, sin_a = rope_cos_sin(positions, MLA_ROPE)
    cos_b, sin_b = rope_cos_sin(positions, NSA_DH)
    h = x
    shared = None
    for layer in range(DEPTH):
        h = h + 0.5 * swiglu(rms_norm(h, ffn1_norm[layer]), ffn1_w_gate[layer], ffn1_w_up[layer], ffn1_w_down[layer])
        u = rms_norm(h, mix_norm[layer])
        if layer < N_A_LAYERS:
            a = layer
            h = h + mla_mixer(u, cos_a, sin_a, mla_w_in[a], mla_g_cq[a], mla_g_ckv[a], mla_w_uq[a],
                              mla_w_ukv[a], mla_g_q[a], mla_g_k[a], mla_w_o[a])
        else:
            b = layer - N_A_LAYERS
            h = h + nsa_mixer(u, cos_b, sin_b, shared, nsa_w_in[b], nsa_b_gate[b], nsa_g_q[b], nsa_w_o[b])
        h = h + 0.5 * swiglu(rms_norm(h, ffn2_norm[layer]), ffn2_w_gate[layer], ffn2_w_up[layer], ffn2_w_down[layer])
        if layer == N_A_LAYERS - 1:
            shared = nsa_shared_kv(h, cos_b, sin_b, kv_norm, kv_w, cmp_pos_k, cmp_pos_v, cmp_k_w1, cmp_k_b1,
                                   cmp_k_w2, cmp_v_w1, cmp_v_b1, cmp_v_w2, g_k_cmp, g_k_slc, g_k_win)
    return h
```

```cpp
#include <hip/hip_runtime.h>
#include <cstdio>
#include <cstdint>
namespace pg8 {
#define PG8_LAS __attribute__((address_space(3)))
typedef unsigned short bf16_t;
typedef short bf16x8 __attribute__((ext_vector_type(8)));
typedef float f32x4 __attribute__((ext_vector_type(4)));
typedef unsigned u32x4 __attribute__((ext_vector_type(4)));
constexpr int BM = 256, BK = 64, HALF = 128, HTB = HALF * BK * 2  , STAGE_BYTES = 8 * HTB, NXCD = 8, WGM = 8;

__host__ __device__ __forceinline__ int lds_byte(int r, int c) { const int st = (r >> 4) * 2 + (c >> 5), rr = r & 15, cc = c & 31, ob = rr * 64 + cc * 2; return st * 1024 + (ob ^ (((ob >> 9) & 1) << 5)); }
__host__ __device__ __forceinline__ void stage_rc(int b, int& R, int& C) { const int st = b / 1024, sb = b % 1024, swz = sb ^ (((sb >> 9) & 1) << 5); R = (st >> 1) * 16 + swz / 64; C = (st & 1) * 32 + (swz % 64) / 2; }
__host__ __device__ __forceinline__ int perm32(int rho) { const int n = rho >> 4, i = rho & 15; return 8 * (i >> 2) + 4 * n + (i & 3); }

struct Unit { int pm, pn; };
struct Gemm { const bf16_t* A; const bf16_t* Bt; int M, N, K, lda; };

struct StaticOrder {
    int nM, nN, nwg, G, c;
    __host__ __device__ __forceinline__ void init(int M, int N, int G_, int c_) { nM = M / BM; nN = N / BM; nwg = nM * nN; G = G_; c = c_; }
    __host__ __device__ __forceinline__ bool next(int i, Unit& u) const {
        const long L = (long)i * G + c; if (L >= nwg) return false;
        int wgid = (int)L; { const int q = nwg / NXCD, r = nwg % NXCD, xcd = wgid % NXCD, off = wgid / NXCD; wgid = (xcd < r ? xcd * (q + 1) : r * (q + 1) + (xcd - r) * q) + off; }
        const int nig = WGM * nN, gid = wgid / nig, fm = gid * WGM, gsz = (nM - fm) < WGM ? (nM - fm) : WGM;
        u.pm = fm + ((wgid % nig) % gsz); u.pn = (wgid % nig) / gsz; return true;
    }
    __device__ __forceinline__ void a_ready(const Unit&) const {}
    __device__ __forceinline__ void done(const Unit&) const {}
};

__device__ __forceinline__ unsigned cvt_pk_bf16(float lo, float hi) { unsigned r; asm volatile("s_nop 0\n\tv_cvt_pk_bf16_f32 %0, %1, %2\n\ts_nop 1" : "=v"(r) : "v"(lo), "v"(hi)); return r; }
constexpr float RMS_EPS = 1e-6f;
__device__ __forceinline__ float silu_f(float g) { return g * __builtin_amdgcn_rcpf(1.0f + __builtin_amdgcn_exp2f(-1.4426950408889634f * g)); }
__device__ __forceinline__ float sigmoid_f(float g) { return __builtin_amdgcn_rcpf(1.0f + __builtin_amdgcn_exp2f(-1.4426950408889634f * g)); }
__device__ __forceinline__ float shx(float v, int mask, int lane) { return __builtin_bit_cast(float, __builtin_amdgcn_ds_bpermute((lane ^ mask) << 2, __builtin_bit_cast(int, v))); }
__device__ __forceinline__ unsigned shxu(unsigned v, int mask, int lane) { return (unsigned)__builtin_amdgcn_ds_bpermute((lane ^ mask) << 2, (int)v); }
__device__ __forceinline__ float quad_sq(const f32x4 v) { return (v[0] * v[0] + v[1] * v[1]) + (v[2] * v[2] + v[3] * v[3]); }

__device__ __forceinline__ float row_rstd(const float* P, int row, int nparts, float inv_dim, int fq, int lane) {
    float s = 0.f; const float* p = P + (size_t)row * 64;
    if (nparts >= 16) { const int q = nparts >> 2; p += fq * q;
        for (int i = 0; i < q; i += 4) { const f32x4 v = *(const f32x4*)(p + i); s += (v[0] + v[1]) + (v[2] + v[3]); }
        s += shx(s, 16, lane); s += shx(s, 32, lane);
    } else { for (int i = 0; i < nparts; ++i) s += p[i]; }
    return __builtin_amdgcn_rsqf(s * inv_dim + RMS_EPS);
}
struct RsTab { const PG8_LAS float* tab; int pm; };
__device__ __forceinline__ float rs_lookup(const RsTab& t, const Unit& u, int lrow, const float* P, int row, int nparts, float inv_dim, int fq, int lane) {
    return (u.pm == t.pm) ? t.tab[lrow] : row_rstd(P, row, nparts, inv_dim, fq, lane);
}
__device__ __forceinline__ void rs_table_fill(PG8_LAS float* tab, const float* P, int nparts, float inv_dim, int pm, int tid, int lane) {
    const int r = tid >> 1, half = tid & 1; const float* p = P + ((size_t)pm * 256 + r) * 64; float s = 0.f;
    if (nparts >= 8) { const int per = nparts >> 1; p += half * per; for (int i = 0; i < per; i += 4) { const f32x4 v = *(const f32x4*)(p + i); s += (v[0] + v[1]) + (v[2] + v[3]); } }
    else if (half == 0) { for (int i = 0; i < nparts; ++i) s += p[i]; }
    s += shx(s, 1, lane);
    if (half == 0) tab[r] = __builtin_amdgcn_rsqf(s * inv_dim + RMS_EPS);
    __syncthreads();
}
struct EpiSwiGLU {
    static constexpr bool PERM = true, AFTER_DRAIN = false, ALIGN = true;
    bf16_t* O; int ldc; const float* ss; int nparts; float inv_dim; RsTab rt;
    __device__ __forceinline__ void operator()(const f32x4 (&acc)[2][2][4][2], const Unit& u, int wr, int wc, int fr, int fq) const {
        const int row0 = u.pm * BM + wr * 64 + fr, col0 = u.pn * HALF + wc * 32 + 8 * fq;
#ifndef MK_EPI2
#define MK_EPI2 1
#endif
#pragma nounroll
        for (int rep_ = 0; rep_ < MK_EPI2; ++rep_) { asm volatile("" ::: "memory");
#pragma unroll
        for (int ai = 0; ai < 2; ++ai)
#pragma unroll
            for (int m = 0; m < 4; ++m) { const int row = row0 + ai * HALF + m * 16; const float rs = rs_lookup(rt, u, row - u.pm * BM, ss, row, nparts, inv_dim, fq, fq * 16 + fr);
                typedef float f32x2e __attribute__((ext_vector_type(2)));
                float o[8]; const float nr = -1.4426950408889634f * rs, r2 = rs * rs; const f32x2e nr2 = {nr, nr}, rs2 = {r2, r2}, one2 = {1.0f, 1.0f};
#pragma unroll
                for (int n = 0; n < 2; ++n)
#pragma unroll
                    for (int jp = 0; jp < 2; ++jp) { const f32x2e g2 = {acc[ai][0][m][n][2 * jp], acc[ai][0][m][n][2 * jp + 1]}, u2 = {acc[ai][1][m][n][2 * jp], acc[ai][1][m][n][2 * jp + 1]};
                        const f32x2e t2 = g2 * nr2; const f32x2e d2 = (f32x2e){__builtin_amdgcn_exp2f(t2.x), __builtin_amdgcn_exp2f(t2.y)} + one2;
                        const f32x2e q2 = (g2 * u2) * rs2 * (f32x2e){__builtin_amdgcn_rcpf(d2.x), __builtin_amdgcn_rcpf(d2.y)};
                        o[4 * n + 2 * jp] = q2.x; o[4 * n + 2 * jp + 1] = q2.y; }
                u32x4 w; w.x = cvt_pk_bf16(o[0], o[1]); w.y = cvt_pk_bf16(o[2], o[3]); w.z = cvt_pk_bf16(o[4], o[5]); w.w = cvt_pk_bf16(o[6], o[7]);
                *(u32x4*)(O + (size_t)row * ldc + col0) = w; }
        }
    }
};
struct EpiResid {
    static constexpr bool PERM = true, AFTER_DRAIN = false, ALIGN = true;
    const float* xin; bf16_t* hb; float* fout; float* ssout; float scale; int ldc;
    __device__ __forceinline__ static f32x4 lo4(const u32x4 w) { return (f32x4){__builtin_bit_cast(float, w.x << 16), __builtin_bit_cast(float, w.x & 0xffff0000u), __builtin_bit_cast(float, w.y << 16), __builtin_bit_cast(float, w.y & 0xffff0000u)}; }
    __device__ __forceinline__ static f32x4 hi4(const u32x4 w) { return (f32x4){__builtin_bit_cast(float, w.z << 16), __builtin_bit_cast(float, w.z & 0xffff0000u), __builtin_bit_cast(float, w.w << 16), __builtin_bit_cast(float, w.w & 0xffff0000u)}; }
    __device__ __forceinline__ void finish(const f32x4 v0, const f32x4 v1, size_t o2, float& sq) const {
        sq += quad_sq(v0) + quad_sq(v1);
        if (fout) { __builtin_nontemporal_store(v0, (f32x4*)(fout + o2)); __builtin_nontemporal_store(v1, (f32x4*)(fout + o2 + 4)); }
        else { u32x4 w; w.x = cvt_pk_bf16(v0[0], v0[1]); w.y = cvt_pk_bf16(v0[2], v0[3]); w.z = cvt_pk_bf16(v1[0], v1[1]); w.w = cvt_pk_bf16(v1[2], v1[3]); *(u32x4*)(hb + o2) = w; } }
    __device__ __forceinline__ void operator()(const f32x4 (&acc)[2][2][4][2], const Unit& u, int wr, int wc, int fr, int fq) const {
        const int row0 = u.pm * BM + wr * 64 + fr, col0 = u.pn * BM + wc * 32 + 8 * fq;
#pragma unroll
        for (int ai = 0; ai < 2; ++ai) {
            if (xin) {
#pragma unroll
                for (int mp = 0; mp < 2; ++mp) { f32x4 hv[2][2][2];
#pragma unroll
                    for (int mm = 0; mm < 2; ++mm)
#pragma unroll
                        for (int bj = 0; bj < 2; ++bj) { const size_t o2 = (size_t)(row0 + ai * HALF + (2 * mp + mm) * 16) * ldc + col0 + bj * HALF; hv[mm][bj][0] = __builtin_nontemporal_load((const f32x4*)(xin + o2)); hv[mm][bj][1] = __builtin_nontemporal_load((const f32x4*)(xin + o2 + 4)); }
#pragma unroll
                    for (int mm = 0; mm < 2; ++mm) { const int m = 2 * mp + mm, row = row0 + ai * HALF + m * 16; float sq = 0.f;
#pragma unroll
                        for (int bj = 0; bj < 2; ++bj) finish(hv[mm][bj][0] + acc[ai][bj][m][0] * scale, hv[mm][bj][1] + acc[ai][bj][m][1] * scale, (size_t)row * ldc + col0 + bj * HALF, sq);
                        if (ssout) { sq += shx(sq, 16, fq * 16 + fr); sq += shx(sq, 32, fq * 16 + fr); if (fq == 0) ssout[(size_t)row * 64 + u.pn * 4 + wc] = sq; } }
                    asm volatile("" ::: "memory"); }
            } else {
                u32x4 raw[4][2];
#pragma unroll
                for (int m = 0; m < 4; ++m)
#pragma unroll
                    for (int bj = 0; bj < 2; ++bj) raw[m][bj] = *(const u32x4*)(hb + (size_t)(row0 + ai * HALF + m * 16) * ldc + col0 + bj * HALF);
#pragma unroll
                for (int m = 0; m < 4; ++m) { const int row = row0 + ai * HALF + m * 16; float sq = 0.f;
#pragma unroll
                    for (int bj = 0; bj < 2; ++bj) finish(lo4(raw[m][bj]) + acc[ai][bj][m][0] * scale, hi4(raw[m][bj]) + acc[ai][bj][m][1] * scale, (size_t)row * ldc + col0 + bj * HALF, sq);
                    if (ssout) { sq += shx(sq, 16, fq * 16 + fr); sq += shx(sq, 32, fq * 16 + fr); if (fq == 0) ssout[(size_t)row * 64 + u.pn * 4 + wc] = sq; } }
                asm volatile("" ::: "memory"); }
        }
    }
};
struct EpiScaleBf16 {
    static constexpr bool PERM = true, AFTER_DRAIN = false, ALIGN = true;
    bf16_t* O; int ldc; const float* ss; int nparts; float inv_dim; float* ssA; float* ssB; int t0, t1; RsTab rt;
    __device__ __forceinline__ void operator()(const f32x4 (&acc)[2][2][4][2], const Unit& u, int wr, int wc, int fr, int fq) const {
        const int row0 = u.pm * BM + wr * 64 + fr, col0 = u.pn * BM + wc * 32 + 8 * fq;
        float* sso = (u.pn < t0) ? ssA : ((u.pn < t1) ? ssB : nullptr);
#pragma unroll
        for (int ai = 0; ai < 2; ++ai)
#pragma unroll
            for (int m = 0; m < 4; ++m) { const int row = row0 + ai * HALF + m * 16; const float rs = rs_lookup(rt, u, row - u.pm * BM, ss, row, nparts, inv_dim, fq, fq * 16 + fr); float sq = 0.f;
#pragma unroll
                for (int bj = 0; bj < 2; ++bj) { const f32x4 v0 = acc[ai][bj][m][0] * rs, v1 = acc[ai][bj][m][1] * rs; sq += quad_sq(v0) + quad_sq(v1);
                    u32x4 w; w.x = cvt_pk_bf16(v0[0], v0[1]); w.y = cvt_pk_bf16(v0[2], v0[3]); w.z = cvt_pk_bf16(v1[0], v1[1]); w.w = cvt_pk_bf16(v1[2], v1[3]);
                    *(u32x4*)(O + (size_t)row * ldc + col0 + bj * HALF) = w; }
                if (sso) { sq += shx(sq, 16, fq * 16 + fr); sq += shx(sq, 32, fq * 16 + fr); if (fq == 0) sso[(size_t)row * 64 + (u.pn < t0 ? u.pn : u.pn - t0) * 4 + wc] = sq; } }
    }
};
struct EpiScaleF32 {
    static constexpr bool PERM = false, AFTER_DRAIN = false, ALIGN = true;
    float* C; int ldc; const float* ss; int nparts; float inv_dim; RsTab rt;
    __device__ __forceinline__ void operator()(const f32x4 (&acc)[2][2][4][2], const Unit& u, int wr, int wc, int fr, int fq) const {
        const int row0 = u.pm * BM + wr * 64 + fr, col0 = u.pn * BM + wc * 32 + 4 * fq;
#pragma unroll
        for (int ai = 0; ai < 2; ++ai)
#pragma unroll
            for (int m = 0; m < 4; ++m) { const int row = row0 + ai * HALF + m * 16; const float rs = rs_lookup(rt, u, row - u.pm * BM, ss, row, nparts, inv_dim, fq, fq * 16 + fr); float* rowp = C + (size_t)row * ldc + col0;
#pragma unroll
                for (int bj = 0; bj < 2; ++bj)
#pragma unroll
                    for (int n = 0; n < 2; ++n) *(f32x4*)(rowp + bj * HALF + n * 16) = acc[ai][bj][m][n] * rs; }
    }
};
struct EpiNsaIn {
    static constexpr bool PERM = true, AFTER_DRAIN = false, ALIGN = true;
    bf16_t* Q; float* gates; const float* bgate; const float* ss; int nparts; float inv_dim; RsTab rt;
    __device__ __forceinline__ void operator()(const f32x4 (&acc)[2][2][4][2], const Unit& u, int wr, int wc, int fr, int fq) const {
        const int row0 = u.pm * BM + wr * 64 + fr, lc0 = wc * 32 + 8 * fq;
#pragma unroll
        for (int ai = 0; ai < 2; ++ai)
#pragma unroll
            for (int m = 0; m < 4; ++m) { const int row = row0 + ai * HALF + m * 16; const float rs = rs_lookup(rt, u, row - u.pm * BM, ss, row, nparts, inv_dim, fq, fq * 16 + fr);
                if (u.pn < 16) {
#pragma unroll
                    for (int bj = 0; bj < 2; ++bj) { const f32x4 v0 = acc[ai][bj][m][0] * rs, v1 = acc[ai][bj][m][1] * rs;
                        u32x4 w; w.x = cvt_pk_bf16(v0[0], v0[1]); w.y = cvt_pk_bf16(v0[2], v0[3]); w.z = cvt_pk_bf16(v1[0], v1[1]); w.w = cvt_pk_bf16(v1[2], v1[3]);
                        *(u32x4*)(Q + (size_t)row * 4096 + u.pn * BM + lc0 + bj * HALF) = w; }
                } else if (lc0 < 96) {
#pragma unroll
                    for (int n = 0; n < 2; ++n) { const f32x4 b = *(const f32x4*)(bgate + lc0 + 4 * n); f32x4 v = acc[ai][0][m][n] * rs + b;
                        v[0] = sigmoid_f(v[0]); v[1] = sigmoid_f(v[1]); v[2] = sigmoid_f(v[2]); v[3] = sigmoid_f(v[3]);
                        *(f32x4*)(gates + (size_t)row * 96 + lc0 + 4 * n) = v; }
                } }
    }
};
struct EpiGateP {
    static constexpr bool PERM = true, AFTER_DRAIN = false, ALIGN = true;
    float* P; const float* ss; int nparts; float inv_dim; RsTab rt;
    __device__ __forceinline__ void operator()(const f32x4 (&acc)[2][2][4][2], const Unit& u, int wr, int wc, int fr, int fq) const {
        const int row0 = u.pm * BM + wr * 64 + fr, lc0 = wc * 32 + 8 * fq;
#pragma unroll
        for (int ai = 0; ai < 2; ++ai)
#pragma unroll
            for (int m = 0; m < 4; ++m) { const int row = row0 + ai * HALF + m * 16; const float rs = rs_lookup(rt, u, row - u.pm * BM, ss, row, nparts, inv_dim, fq, fq * 16 + fr);
                if (lc0 < 96) {
#pragma unroll
                    for (int n = 0; n < 2; ++n) *(f32x4*)(P + (size_t)row * 96 + lc0 + 4 * n) = acc[ai][0][m][n] * rs; } }
    }
};
struct EpiPartF32 {
    static constexpr bool PERM = false, AFTER_DRAIN = false, ALIGN = true;
    float* C; int ldc;
    __device__ __forceinline__ void operator()(const f32x4 (&acc)[2][2][4][2], const Unit& u, int wr, int wc, int fr, int fq) const {
        const int row0 = u.pm * BM + wr * 64 + fr, col0 = u.pn * BM + wc * 32 + 4 * fq;
#pragma unroll
        for (int ai = 0; ai < 2; ++ai)
#pragma unroll
            for (int m = 0; m < 4; ++m) { float* rowp = C + (size_t)(row0 + ai * HALF + m * 16) * ldc + col0;
#pragma unroll
                for (int bj = 0; bj < 2; ++bj)
#pragma unroll
                    for (int n = 0; n < 2; ++n) *(f32x4*)(rowp + bj * HALF + n * 16) = acc[ai][bj][m][n]; }
    }
};
struct EpiCmpHidden {
    static constexpr bool PERM = true, AFTER_DRAIN = false, ALIGN = true;
    bf16_t* O; const float* b1;
    __device__ __forceinline__ void operator()(const f32x4 (&acc)[2][2][4][2], const Unit& u, int wr, int wc, int fr, int fq) const {
        const int row0 = u.pm * BM + wr * 64 + fr, col0 = wc * 32 + 8 * fq;
#pragma unroll
        for (int ai = 0; ai < 2; ++ai)
#pragma unroll
            for (int m = 0; m < 4; ++m) { const int row = row0 + ai * HALF + m * 16;
#pragma unroll
                for (int bj = 0; bj < 2; ++bj) { const f32x4 b0 = *(const f32x4*)(b1 + col0 + bj * HALF), bb1 = *(const f32x4*)(b1 + col0 + bj * HALF + 4);
                    const f32x4 v0 = acc[ai][bj][m][0] + b0, v1 = acc[ai][bj][m][1] + bb1;
                    u32x4 w; w.x = cvt_pk_bf16(silu_f(v0[0]), silu_f(v0[1])); w.y = cvt_pk_bf16(silu_f(v0[2]), silu_f(v0[3])); w.z = cvt_pk_bf16(silu_f(v1[0]), silu_f(v1[1])); w.w = cvt_pk_bf16(silu_f(v1[2]), silu_f(v1[3]));
                    *(u32x4*)(O + (size_t)row * 256 + col0 + bj * HALF) = w; } }
    }
};

template <class Epi, class Sched, bool ALIGN_EPI = false, bool SP2 = false>
__device__ __forceinline__ void gemm_phase(PG8_LAS unsigned char* lds, const Gemm g, const Sched& S, const Epi& E, const int tid) {
    const int wid = __builtin_amdgcn_readfirstlane(tid >> 6), lane = tid & 63, wr = wid >> 2, wc = wid & 3, fr = lane & 15, fq = lane >> 4;
    const int K = g.K, nt = K / BK;
    unsigned voffA[2], voffB[2];
#pragma unroll
    for (int i = 0; i < 2; ++i) { int R, C; stage_rc(tid * 16 + i * 8192, R, C); const int Rb = Epi::PERM ? ((R & ~31) + perm32(R & 31)) : R;
        voffA[i] = (unsigned)(R * g.lda + C) * 2u; voffB[i] = (unsigned)(Rb * K + C) * 2u; }
    const size_t kstep = (size_t)(BK * 2);
    const size_t hstepA = (size_t)HALF * g.lda * 2, hstepB = (size_t)HALF * K * 2;
    const size_t tstepA = 2 * hstepA, tstepB = 2 * hstepB;
    const unsigned ldsw = (unsigned)wid * 1024u;
    const int aoff = lds_byte(wr * 64 + fr, fq * 8), boff = lds_byte(wc * 32 + fr, fq * 8);
#define PG8_SA(b, h) (((b) * 2 + (h)) * HTB)
#define PG8_SB(b, h) ((4 + (b) * 2 + (h)) * HTB)
#define PG8_STAGE(bufoff, gbase, voff) do { _Pragma("unroll") for (int _i = 0; _i < 2; ++_i) \
        __builtin_amdgcn_global_load_lds((const unsigned*)((const char*)(gbase) + (voff)[_i]), (PG8_LAS unsigned*)(lds + (bufoff) + ldsw + _i * 8192), 16, 0, 0); } while (0)
#define PG8_LDA(dst, b, h) do { _Pragma("unroll") for (int m = 0; m < 4; ++m) _Pragma("unroll") for (int k = 0; k < 2; ++k) dst[m][k] = *(const PG8_LAS bf16x8*)(lds + PG8_SA(b, h) + aoff + m * 2048 + k * 1024); } while (0)
#define PG8_LDB(dst, b, h) do { _Pragma("unroll") for (int n = 0; n < 2; ++n) _Pragma("unroll") for (int k = 0; k < 2; ++k) dst[n][k] = *(const PG8_LAS bf16x8*)(lds + PG8_SB(b, h) + boff + n * 2048 + k * 1024); } while (0)
#define PG8_MMA(ai, bj, At, Bt) do { __builtin_amdgcn_s_setprio(1); _Pragma("unroll") for (int m = 0; m < 4; ++m) _Pragma("unroll") for (int n = 0; n < 2; ++n) _Pragma("unroll") for (int k = 0; k < 2; ++k) \
        acc[ai][bj][m][n] = __builtin_amdgcn_mfma_f32_16x16x32_bf16(Bt[n][k], At[m][k], acc[ai][bj][m][n], 0, 0, 0); __builtin_amdgcn_s_setprio(0); } while (0)
#define PG8_WAIT_V(n) asm volatile("s_waitcnt vmcnt(" #n ")" ::: "memory")
#define PG8_WAIT_L(n) asm volatile("s_waitcnt lgkmcnt(" #n ")" ::: "memory")
#define PG8_BAR __builtin_amdgcn_s_barrier()
#define PG8_SCHED __builtin_amdgcn_sched_barrier(0)
    Unit cur, nxt; int ui = 0;
    if (!S.next(0, cur)) return;
    f32x4 acc[2][2][4][2];
#pragma unroll
    for (int a = 0; a < 2; ++a)
#pragma unroll
        for (int b = 0; b < 2; ++b)
#pragma unroll
            for (int m = 0; m < 4; ++m)
#pragma unroll
                for (int n = 0; n < 2; ++n) acc[a][b][m][n] = (f32x4){0.f, 0.f, 0.f, 0.f};
    bf16x8 At[4][2], B0[2][2], B1[2][2];
    const char* cA = (const char*)g.A + (size_t)cur.pm * tstepA; const char* cB = (const char*)g.Bt + (size_t)cur.pn * tstepB;
    S.a_ready(cur);
    if constexpr (SP2) {
        PG8_STAGE(PG8_SB(0, 0), cB, voffB); PG8_STAGE(PG8_SB(0, 1), cB + hstepB, voffB); PG8_STAGE(PG8_SA(0, 0), cA, voffA); PG8_STAGE(PG8_SA(0, 1), cA + hstepA, voffA);
        if (wr == 1) PG8_BAR;
        PG8_WAIT_V(2); PG8_BAR;
        PG8_STAGE(PG8_SB(1, 0), cB + kstep, voffB); PG8_STAGE(PG8_SA(1, 0), cA + kstep, voffA); PG8_STAGE(PG8_SB(1, 1), cB + hstepB + kstep, voffB);
        PG8_WAIT_V(6); PG8_BAR;
    } else {
        PG8_STAGE(PG8_SB(0, 0), cB, voffB); PG8_STAGE(PG8_SA(0, 0), cA, voffA); PG8_STAGE(PG8_SB(0, 1), cB + hstepB, voffB); PG8_STAGE(PG8_SA(0, 1), cA + hstepA, voffA);
        if (wr == 1) PG8_BAR;
        PG8_WAIT_V(4); PG8_BAR;
        PG8_STAGE(PG8_SB(1, 0), cB + kstep, voffB); PG8_STAGE(PG8_SA(1, 0), cA + kstep, voffA); PG8_STAGE(PG8_SB(1, 1), cB + hstepB + kstep, voffB);
        PG8_WAIT_V(6); PG8_BAR;
    }
    for (;;) {
        const bool has_next = S.next(ui + 1, nxt);
        const char* nA = has_next ? (const char*)g.A + (size_t)nxt.pm * tstepA : cA; const char* nB = has_next ? (const char*)g.Bt + (size_t)nxt.pn * tstepB : cB;
        for (int t = 0; t < nt; t += 2) {
            const bool last = (t == nt - 2);
            const char* a1 = cA + (size_t)(t + 1) * kstep;
            const char* a2 = last ? nA : cA + (size_t)(t + 2) * kstep; const char* b2 = last ? nB : cB + (size_t)(t + 2) * kstep;
            const char* a3 = a2 + kstep; const char* b3 = b2 + kstep;
            if (last && has_next) S.a_ready(nxt);
            if constexpr (SP2) {
            PG8_LDB(B0, 0, 0); PG8_LDB(B1, 0, 1); PG8_SCHED; PG8_LDA(At, 0, 0); PG8_STAGE(PG8_SA(1, 1), a1 + hstepA, voffA);
            PG8_WAIT_V(8); PG8_WAIT_L(0); PG8_BAR; PG8_MMA(0, 0, At, B0); PG8_MMA(0, 1, At, B1); PG8_BAR; PG8_SCHED;
            PG8_LDA(At, 0, 1); PG8_STAGE(PG8_SB(0, 0), b2, voffB); PG8_STAGE(PG8_SB(0, 1), b2 + hstepB, voffB); PG8_STAGE(PG8_SA(0, 0), a2, voffA);
            PG8_WAIT_V(8); PG8_WAIT_L(0); PG8_BAR; PG8_MMA(1, 0, At, B0); PG8_MMA(1, 1, At, B1); PG8_BAR; PG8_SCHED;
            PG8_LDB(B0, 1, 0); PG8_LDB(B1, 1, 1); PG8_SCHED; PG8_LDA(At, 1, 0); PG8_STAGE(PG8_SA(0, 1), a2 + hstepA, voffA);
            PG8_WAIT_V(8); PG8_WAIT_L(0); PG8_BAR; PG8_MMA(0, 0, At, B0); PG8_MMA(0, 1, At, B1); PG8_BAR; PG8_SCHED;
            PG8_LDA(At, 1, 1); PG8_STAGE(PG8_SB(1, 0), b3, voffB); PG8_STAGE(PG8_SB(1, 1), b3 + hstepB, voffB); PG8_STAGE(PG8_SA(1, 0), a3, voffA);
            PG8_WAIT_V(8); PG8_WAIT_L(0); PG8_BAR; PG8_MMA(1, 0, At, B0); PG8_MMA(1, 1, At, B1); PG8_BAR; PG8_SCHED;
            } else {
            PG8_LDB(B0, 0, 0); PG8_SCHED; PG8_LDA(At, 0, 0); PG8_STAGE(PG8_SA(1, 1), a1 + hstepA, voffA);
            PG8_WAIT_L(8); PG8_BAR; PG8_WAIT_L(0); PG8_MMA(0, 0, At, B0); PG8_BAR; PG8_SCHED;
            PG8_LDB(B1, 0, 1); PG8_STAGE(PG8_SB(0, 0), b2, voffB);
            PG8_BAR; PG8_WAIT_L(0); PG8_MMA(0, 1, At, B1); PG8_BAR;
            PG8_LDA(At, 0, 1); PG8_STAGE(PG8_SA(0, 0), a2, voffA);
            PG8_BAR; PG8_WAIT_L(0); PG8_MMA(1, 0, At, B0); PG8_BAR; PG8_SCHED;
            PG8_STAGE(PG8_SB(0, 1), b2 + hstepB, voffB);
            PG8_WAIT_V(6); PG8_BAR; PG8_MMA(1, 1, At, B1); PG8_BAR;
            PG8_LDB(B0, 1, 0); PG8_SCHED; PG8_LDA(At, 1, 0); PG8_STAGE(PG8_SA(0, 1), a2 + hstepA, voffA);
            PG8_WAIT_L(8); PG8_BAR; PG8_WAIT_L(0); PG8_MMA(0, 0, At, B0); PG8_BAR; PG8_SCHED;
            PG8_LDB(B1, 1, 1); PG8_STAGE(PG8_SB(1, 0), b3, voffB);
            PG8_BAR; PG8_WAIT_L(0); PG8_MMA(0, 1, At, B1); PG8_BAR;
            PG8_LDA(At, 1, 1); PG8_STAGE(PG8_SA(1, 0), a3, voffA);
            PG8_BAR; PG8_WAIT_L(0); PG8_MMA(1, 0, At, B0); PG8_BAR; PG8_SCHED;
            PG8_STAGE(PG8_SB(1, 1), b3 + hstepB, voffB);
            PG8_WAIT_V(6); PG8_BAR; PG8_MMA(1, 1, At, B1); PG8_BAR;
            }
        }
        if constexpr (ALIGN_EPI) { if (wr == 0) PG8_BAR; }
        if constexpr (!Epi::AFTER_DRAIN) { E(acc, cur, wr, wc, fr, fq); S.done(cur); }
        if (!has_next) break;
#pragma unroll
        for (int a = 0; a < 2; ++a)
#pragma unroll
            for (int b = 0; b < 2; ++b)
#pragma unroll
                for (int m = 0; m < 4; ++m)
#pragma unroll
                    for (int n = 0; n < 2; ++n) acc[a][b][m][n] = (f32x4){0.f, 0.f, 0.f, 0.f};
        cur = nxt; cA = nA; cB = nB; ++ui;
        if constexpr (ALIGN_EPI) { if (wr == 1) PG8_BAR; }
    }
    PG8_WAIT_V(0);
    if constexpr (!ALIGN_EPI) { if (wr == 0) PG8_BAR; }
    PG8_BAR;
    if constexpr (Epi::AFTER_DRAIN) { E.fused(acc, cur, wr, wc, fr, fq, lds, wid, lane); S.done(cur); }
#undef PG8_SA
#undef PG8_SB
#undef PG8_STAGE
#undef PG8_LDA
#undef PG8_LDB
#undef PG8_MMA
#undef PG8_WAIT_V
#undef PG8_WAIT_L
#undef PG8_BAR
#undef PG8_SCHED
}
}

using pg8::bf16x8; using pg8::f32x4; using pg8::u32x4; using pg8::cvt_pk_bf16;
typedef unsigned short bf16;
typedef float f32x16 __attribute__((ext_vector_type(16)));
typedef short s16x4 __attribute__((ext_vector_type(4)));
typedef unsigned u32x2 __attribute__((ext_vector_type(2)));

constexpr int DM = 4096, BATCH = 4, SEQ = 2048, T = BATCH * SEQ, FF = 6144, DEPTH = 4;
constexpr int MLA_H = 32, QLORA = 1024, KVLORA = 512, MLA_QK = 192, MLA_IN = 1600, MLA_IN_P = 1792;
constexpr int NSA_G = 4, HPG = 8, DH = 128, NKV = 3072, NSA_IN = 4192, NSA_IN_P = 4352;
constexpr int NCMP = 127, CMP_ROWS = BATCH * NCMP * NSA_G  , CMP_ROWS_P = 2048, CMP_HID = 256;
constexpr float EPS = 1e-6f, NEGF = -1e30f, LOG2E = 1.4426950408889634f;
constexpr int NWAVES = 8, NTHREADS = 512;

constexpr size_t MiB = 1u << 20;
constexpr size_t WS_CTL = 0, CTL_ZERO_BYTES = 64 * 1024;
constexpr int CW_BAR = 4096;
constexpr size_t SS_SLOT_B = (size_t)8192 * 64 * 4;
constexpr int SS_CQ = 12, SS_CKV = 14;
constexpr size_t FFN_GU_B = (size_t)2 * FF * DM * 2, FFN_D_B = (size_t)DM * FF * 2, FFN_B = FFN_GU_B + FFN_D_B;
constexpr size_t SS_OFF = 1 * MiB;
constexpr size_t WS_FFN = SS_OFF + 16 * SS_SLOT_B;
constexpr size_t WS_MLA = WS_FFN + 8 * FFN_B;
constexpr size_t MLA_WIN_B = (size_t)MLA_IN_P * DM * 2, MLA_WUQ_B = (size_t)6144 * QLORA * 2, MLA_WUKV_B = (size_t)8192 * KVLORA * 2, WO_B = (size_t)DM * DM * 2;
constexpr size_t MLA_B = MLA_WIN_B + MLA_WUQ_B + MLA_WUKV_B + WO_B;
constexpr size_t WS_NSA = WS_MLA + 2 * MLA_B;
constexpr size_t NSA_WIN_B = (size_t)NSA_IN_P * DM * 2, NSA_B = NSA_WIN_B + WO_B;
constexpr size_t WS_KVW = WS_NSA + 2 * NSA_B, KVW_B = (size_t)NKV * DM * 2;
constexpr size_t WS_CW1 = WS_KVW + KVW_B, CW1_B = (size_t)CMP_HID * 4096 * 2;
constexpr size_t WS_HB = WS_CW1 + 2 * CW1_B;
constexpr size_t WS_ACT = WS_HB + (size_t)T * DM * 2;
constexpr size_t WS_CBUF = WS_ACT + (size_t)T * FF * 2;
constexpr size_t WS_QRAW = WS_CBUF + (size_t)T * MLA_IN_P * 2;
constexpr size_t WS_KVRAW = WS_QRAW + (size_t)T * 6144 * 2;
constexpr size_t WS_QF = WS_KVRAW + (size_t)T * 8192 * 2;
constexpr size_t WS_KF = WS_QF + (size_t)T * 32 * 192 * 2;
constexpr size_t WS_OB = WS_KF + (size_t)T * 32 * 192 * 2;
constexpr size_t WS_GATES = WS_OB + (size_t)T * DM * 2;
constexpr size_t WS_SEL = WS_GATES + (size_t)T * 96 * 4;
constexpr size_t WS_KVS = WS_SEL + (size_t)BATCH * NSA_G * SEQ * 4;
constexpr size_t WS_KSLC = WS_KVS + (size_t)T * NKV * 4;
constexpr size_t WS_KWIN = WS_KSLC + (size_t)T * 512 * 2, WS_VSLC = WS_KWIN + (size_t)T * 512 * 2, WS_VWIN = WS_VSLC + (size_t)T * 512 * 2;
constexpr size_t WS_BLKK = WS_VWIN + (size_t)T * 512 * 2, WS_BLKV = WS_BLKK + (size_t)CMP_ROWS_P * 4096 * 2;
constexpr size_t WS_HIDK = WS_BLKV + (size_t)CMP_ROWS_P * 4096 * 2, WS_HIDV = WS_HIDK + (size_t)CMP_ROWS_P * 256 * 2;
constexpr size_t WS_KC = WS_HIDV + (size_t)CMP_ROWS_P * 256 * 2, WS_VC = WS_KC + (size_t)16 * 128 * 128 * 2;
constexpr size_t WS_TABA = WS_VC + (size_t)16 * 128 * 128 * 2;
constexpr size_t WS_TABB = WS_TABA + (size_t)T * 32 * 4 * 2;
constexpr size_t WS_GP = WS_TABB + (size_t)T * 64 * 4 * 2;
constexpr size_t WS_END = WS_GP + (size_t)8 * T * 96 * 4;
constexpr size_t NSA_WQ_B = (size_t)4096 * DM * 2, GSL_B = (size_t)256 * 512 * 2;
static_assert((CW_BAR + 3456) * 4 <= (int)CTL_ZERO_BYTES && CTL_ZERO_BYTES <= SS_OFF, "zeroed region");
static_assert(WS_HB % 256 == 0 && WS_END < ((size_t)3000 << 20), "d_ws map");

constexpr int RING_BYTES = 131072;
constexpr int LDSCTL_OFF = RING_BYTES, MISC_OFF = LDSCTL_OFF + 320, RSTAB_OFF = LDSCTL_OFF + 1024;
constexpr int LDS_BYTES = 147456;

#define GAS __attribute__((address_space(1)))
#define LAS __attribute__((address_space(3)))
#define RLX_AGENT __ATOMIC_RELAXED, __HIP_MEMORY_SCOPE_AGENT
#define LDS_WAIT() asm volatile("s_waitcnt lgkmcnt(0)" ::: "memory")
__device__ __forceinline__ unsigned f2bf(float f) { unsigned u = __builtin_bit_cast(unsigned, f); return (u + 0x7fffu + ((u >> 16) & 1u)) >> 16; }
__device__ __forceinline__ unsigned pk2(float lo, float hi) { return f2bf(lo) | (f2bf(hi) << 16); }
__device__ __forceinline__ float bf2f(bf16 b) { return __builtin_bit_cast(float, (unsigned)b << 16); }
using pg8::shx; using pg8::shxu;
__device__ __forceinline__ float wave_sum(float v, int lane) {
#pragma unroll
    for (int o = 1; o < 64; o <<= 1) v += shx(v, o, lane);
    return v;
}

#define XB_TMO      128
#define XB_XCNT(j)  (256  + 64 * (j))
#define XB_XSUB(j)  (1280 + 64 * (j))
#define XB_XGEN(j)  (2304 + 64 * (j))
#define XB_TOP      3328
#define XB_TOPGEN   3392
#define XCD_BAR_WORDS 3456
#define XB_SPIN_CAP (1u << 18)

__device__ __forceinline__ unsigned xb_ld(unsigned* p)              { return __hip_atomic_load(p, __ATOMIC_RELAXED, __HIP_MEMORY_SCOPE_AGENT); }
__device__ __forceinline__ unsigned xb_add(unsigned* p, unsigned v) { return __hip_atomic_fetch_add(p, v, __ATOMIC_RELAXED, __HIP_MEMORY_SCOPE_AGENT); }
__device__ __forceinline__ unsigned xb_xcc_id() { return (unsigned)__builtin_amdgcn_s_getreg((3 << 11) | 20) & 0xFu; }
#define XB_SPIN(cond, bar) do { unsigned _sp = 0; while (cond) { __builtin_amdgcn_s_sleep(1); \
    if ((++_sp & 255u) == 0u) { if (xb_ld(&(bar)[XB_TMO])) break; if (_sp > XB_SPIN_CAP) { atomicAdd(&(bar)[XB_TMO], 1u); break; } } } } while (0)

struct XcdBarrier {
    unsigned* bar; unsigned x;
    volatile LAS unsigned* st;
};

__device__ __forceinline__ XcdBarrier xcd_barrier_post(unsigned* bar, volatile LAS unsigned* st) {
    XcdBarrier b; b.bar = bar; b.x = xb_xcc_id(); b.st = st;
    if (threadIdx.x == 0) (void)xb_add(&bar[XB_XCNT(b.x)], 1u);
    return b;
}
__device__ __forceinline__ void xcd_barrier_complete(unsigned* bar, unsigned x, unsigned& nloc, unsigned& nx) {
    const unsigned G = gridDim.x * gridDim.y * gridDim.z;
    unsigned sum, cnt, mine, sp = 0u;
    for (;;) {
        sum = 0u; cnt = 0u; mine = 0u;
#pragma unroll
        for (unsigned j = 0; j < 16; ++j) { const unsigned c = xb_ld(&bar[XB_XCNT(j)]); sum += c; cnt += (c > 0u) ? 1u : 0u; mine = (j == x) ? c : mine; }
        if (sum == G) break;
        __builtin_amdgcn_s_sleep(1);
        if ((++sp & 255u) == 0u) { if (xb_ld(&bar[XB_TMO])) break; if (sp > XB_SPIN_CAP) { atomicAdd(&bar[XB_TMO], 1u); break; } }
    }
    nloc = mine > 0u ? mine : 1u; nx = cnt > 0u ? cnt : 1u;
}

__device__ __forceinline__ void xcd_barrier(const XcdBarrier& b) {
    asm volatile("s_waitcnt vmcnt(0)" ::: "memory");
    __syncthreads();
    if (threadIdx.x == 0) {
        unsigned* bar = b.bar;
        __builtin_amdgcn_s_waitcnt(0);
        unsigned nloc = b.st[0], nx = b.st[1];
        if (nloc == 0u) { xcd_barrier_complete(bar, b.x, nloc, nx); b.st[0] = nloc; b.st[1] = nx; }
        const unsigned old = xb_add(&bar[XB_XSUB(b.x)], 1u);
        const unsigned gen = old / nloc;
        if (old + 1u == (gen + 1u) * nloc) {
            __builtin_amdgcn_fence(__ATOMIC_RELEASE, "agent");
            asm volatile("s_waitcnt vmcnt(0)" ::: "memory");
            const unsigned og = xb_add(&bar[XB_TOP], 1u);
            const unsigned tg = og / nx;
            if (og + 1u == (tg + 1u) * nx) xb_add(&bar[XB_TOPGEN], 1u);
            else XB_SPIN(xb_ld(&bar[XB_TOPGEN]) == tg, bar);
            __builtin_amdgcn_fence(__ATOMIC_ACQUIRE, "agent");
            xb_add(&bar[XB_XGEN(b.x)], 1u);
            asm volatile("s_waitcnt vmcnt(0)" ::: "memory");
        } else {
            XB_SPIN(xb_ld(&bar[XB_XGEN(b.x)]) == gen, bar);
            __builtin_amdgcn_fence(__ATOMIC_ACQUIRE, "agent");
            asm volatile("s_waitcnt vmcnt(0)" ::: "memory");
        }
    }
    __syncthreads();
}

typedef GAS unsigned gu32;

struct Args { const void* in[36]; float* out; unsigned char* ws; int ph_lo, ph_hi; };
enum { I_X = 0, I_POS, I_F1N, I_F1G, I_F1U, I_F1D, I_MIXN, I_F2N, I_F2G, I_F2U, I_F2D, I_MWIN, I_MGCQ, I_MGCKV, I_MWUQ, I_MWUKV, I_MGQ, I_MGK, I_MWO,
       I_KVN, I_KVW, I_CPK, I_CPV, I_CKW1, I_CKB1, I_CKW2, I_CVW1, I_CVB1, I_CVW2, I_GKC, I_GKS, I_GKW, I_NWIN, I_NBG, I_NGQ, I_NWO };

struct CvtJob { const float* W; const float* gain; bf16* WT; int K, N, mode, ldw; };
constexpr int N_CVT_JOBS = 42;
template <class ArgsT> __device__ __forceinline__ CvtJob get_job(const ArgsT& a, int j) {
    CvtJob jb; unsigned char* ws = a.ws; jb.ldw = 0;
    if (j < 24) { const int l = j / 6, r = j % 6, which = r / 3, mat = r % 3;
        const float* norm = (const float*)a.in[which ? I_F2N : I_F1N] + (size_t)l * DM;
        bf16* gu = (bf16*)(ws + WS_FFN + (size_t)(l * 2 + which) * FFN_B);
        if (mat == 0)      { jb.W = (const float*)a.in[which ? I_F2G : I_F1G] + (size_t)l * DM * FF; jb.gain = norm; jb.WT = gu; jb.K = DM; jb.N = FF; jb.mode = 1; }
        else if (mat == 1) { jb.W = (const float*)a.in[which ? I_F2U : I_F1U] + (size_t)l * DM * FF; jb.gain = norm; jb.WT = gu; jb.K = DM; jb.N = FF; jb.mode = 2; }
        else               { jb.W = (const float*)a.in[which ? I_F2D : I_F1D] + (size_t)l * FF * DM; jb.gain = nullptr; jb.WT = (bf16*)((unsigned char*)gu + FFN_GU_B); jb.K = FF; jb.N = DM; jb.mode = 0; }
    } else if (j < 32) { const int l = (j - 24) / 4, r = (j - 24) % 4; unsigned char* base = ws + WS_MLA + (size_t)l * MLA_B; jb.mode = 0;
        if (r == 0)      { jb.W = (const float*)a.in[I_MWIN] + (size_t)l * DM * MLA_IN; jb.gain = (const float*)a.in[I_MIXN] + (size_t)l * DM; jb.WT = (bf16*)base; jb.K = DM; jb.N = MLA_IN; }
        else if (r == 1) { jb.W = (const float*)a.in[I_MWUQ] + (size_t)l * QLORA * 6144; jb.gain = (const float*)a.in[I_MGCQ] + (size_t)l * QLORA; jb.WT = (bf16*)(base + MLA_WIN_B); jb.K = QLORA; jb.N = 6144; }
        else if (r == 2) { jb.W = (const float*)a.in[I_MWUKV] + (size_t)l * KVLORA * 8192; jb.gain = (const float*)a.in[I_MGCKV] + (size_t)l * KVLORA; jb.WT = (bf16*)(base + MLA_WIN_B + MLA_WUQ_B); jb.K = KVLORA; jb.N = 8192; }
        else             { jb.W = (const float*)a.in[I_MWO] + (size_t)l * DM * DM; jb.gain = nullptr; jb.WT = (bf16*)(base + MLA_WIN_B + MLA_WUQ_B + MLA_WUKV_B); jb.K = DM; jb.N = DM; }
    } else if (j < 38) { const int l = (j - 32) / 3, r = (j - 32) % 3; unsigned char* base = ws + WS_NSA + (size_t)l * NSA_B; jb.mode = 0;
        if (r == 0)      { jb.W = (const float*)a.in[I_NWIN] + (size_t)l * DM * NSA_IN; jb.gain = (const float*)a.in[I_MIXN] + (size_t)(2 + l) * DM; jb.WT = (bf16*)base; jb.K = DM; jb.N = 4096; jb.ldw = NSA_IN; }
        else if (r == 1) { jb.W = (const float*)a.in[I_NWIN] + (size_t)l * DM * NSA_IN + 4096; jb.gain = (const float*)a.in[I_MIXN] + (size_t)(2 + l) * DM; jb.WT = (bf16*)(base + NSA_WQ_B); jb.K = DM; jb.N = 96; jb.ldw = NSA_IN; jb.mode = 3; }
        else             { jb.W = (const float*)a.in[I_NWO] + (size_t)l * DM * DM; jb.gain = nullptr; jb.WT = (bf16*)(base + NSA_WIN_B); jb.K = DM; jb.N = DM; }
    } else if (j == 38) { jb.W = (const float*)a.in[I_KVW]; jb.gain = (const float*)a.in[I_KVN]; jb.WT = (bf16*)(ws + WS_KVW); jb.K = DM; jb.N = 2048; jb.ldw = NKV; jb.mode = 0; }
    else if (j == 41)   { jb.W = (const float*)a.in[I_KVW] + 2048; jb.gain = (const float*)a.in[I_KVN]; jb.WT = (bf16*)(ws + WS_KVW + (size_t)2048 * DM * 2); jb.K = DM; jb.N = 1024; jb.ldw = NKV; jb.mode = 4; }
    else if (j == 39)   { jb.W = (const float*)a.in[I_CKW1]; jb.gain = nullptr; jb.WT = (bf16*)(ws + WS_CW1); jb.K = 4096; jb.N = CMP_HID; jb.mode = 3; }
    else if (j == 40)   { jb.W = (const float*)a.in[I_CVW1]; jb.gain = nullptr; jb.WT = (bf16*)(ws + WS_CW1 + CW1_B); jb.K = 4096; jb.N = CMP_HID; jb.mode = 3; }
    if (jb.ldw == 0) jb.ldw = jb.N;
    return jb;
}
__device__ __forceinline__ void cvt_item(const float* W, const float* gain, bf16* WT, int K, int N, int ldw, int mode, LAS float* scr, int item, int lane) {
    const int nblk = N / 32, kb = item / nblk, nb = item - kb * nblk, k0 = 64 * kb, n0 = 32 * nb;
    float wv[32];
#pragma unroll
    for (int i = 0; i < 32; ++i) wv[i] = __builtin_nontemporal_load(&W[(size_t)(k0 + 2 * i + (lane >> 5)) * ldw + n0 + (lane & 31)]);
    if (gain) {
#pragma unroll
        for (int i = 0; i < 32; ++i) wv[i] *= gain[k0 + 2 * i + (lane >> 5)]; }
#pragma unroll
    for (int i = 0; i < 32; ++i) scr[(2 * i + (lane >> 5)) * 33 + (lane & 31)] = wv[i];
    LDS_WAIT(); asm volatile("" ::: "memory");
    const int c = lane & 7;
    const int drow0 = (mode == 0) ? n0 : (256 * (n0 >> 7) + (n0 & 127) + (mode == 2 ? 128 : 0));
#pragma unroll
    for (int j = 0; j < 4; ++j) { const int n = (lane >> 3) + 8 * j; const LAS float* s = scr + (8 * c) * 33 + n;
        u32x4 o; o.x = pk2(s[0 * 33], s[1 * 33]); o.y = pk2(s[2 * 33], s[3 * 33]); o.z = pk2(s[4 * 33], s[5 * 33]); o.w = pk2(s[6 * 33], s[7 * 33]);
        bf16* dst = (mode == 3) ? WT + (size_t)(k0 >> 9) * (256 * 512) + (size_t)(n0 + n) * 512 + (k0 & 511) + 8 * c
                  : (mode == 4) ? WT + (size_t)(k0 >> 11) * (1024 * 2048) + (size_t)(n0 + n) * 2048 + (k0 & 2047) + 8 * c : WT + (size_t)(drow0 + n) * K + k0 + 8 * c;
        *(GAS u32x4*)dst = o; }
    LDS_WAIT(); asm volatile("" ::: "memory");
}
__device__ __forceinline__ void cvt_load(float (&wv)[32], float& gv, const CvtJob& jb, int item, int lane) {
    const int nblk = jb.N / 32, kb = item / nblk, nb = item - kb * nblk, k0 = 64 * kb, n0 = 32 * nb;
    const float* p = jb.W + (size_t)(k0 + (lane >> 5)) * jb.ldw + n0 + (lane & 31);
#pragma unroll
    for (int i = 0; i < 32; ++i) wv[i] = __builtin_nontemporal_load(p + (size_t)(2 * i) * jb.ldw);
    gv = jb.gain ? jb.gain[k0 + lane] : 1.0f;
}
__device__ __forceinline__ void cvt_finish(float (&wv)[32], const float gv, const CvtJob& jb, int item, LAS float* scr, int lane) {
    const int nblk = jb.N / 32, kb = item / nblk, nb = item - kb * nblk, k0 = 64 * kb, n0 = 32 * nb, mode = jb.mode, K = jb.K;
    if (jb.gain) {
#pragma unroll
        for (int i = 0; i < 32; ++i) wv[i] *= __builtin_bit_cast(float, __builtin_amdgcn_ds_bpermute((2 * i + (lane >> 5)) * 4, __builtin_bit_cast(int, gv))); }
#pragma unroll
    for (int i = 0; i < 32; ++i) scr[(2 * i + (lane >> 5)) * 33 + (lane & 31)] = wv[i];
    LDS_WAIT(); asm volatile("" ::: "memory");
    const int c = lane & 7;
    const int drow0 = (mode == 0) ? n0 : (256 * (n0 >> 7) + (n0 & 127) + (mode == 2 ? 128 : 0));
#pragma unroll
    for (int j = 0; j < 4; ++j) { const int n = (lane >> 3) + 8 * j; const LAS float* s = scr + (8 * c) * 33 + n;
        u32x4 o; o.x = pk2(s[0 * 33], s[1 * 33]); o.y = pk2(s[2 * 33], s[3 * 33]); o.z = pk2(s[4 * 33], s[5 * 33]); o.w = pk2(s[6 * 33], s[7 * 33]);
        bf16* dst = (mode == 3) ? jb.WT + (size_t)(k0 >> 9) * (256 * 512) + (size_t)(n0 + n) * 512 + (k0 & 511) + 8 * c
                  : (mode == 4) ? jb.WT + (size_t)(k0 >> 11) * (1024 * 2048) + (size_t)(n0 + n) * 2048 + (k0 & 2047) + 8 * c : jb.WT + (size_t)(drow0 + n) * K + k0 + 8 * c;
        *(GAS u32x4*)dst = o; }
    LDS_WAIT(); asm volatile("" ::: "memory");
}
template <class ArgsT> __device__ __forceinline__ bool cvt_next(const ArgsT& a, int& j, const int jend, int& it, CvtJob& jb, const int gw) {
    while (j < jend) { jb = get_job(a, j); if (it < (jb.K / 64) * (jb.N / 32)) return true; ++j; it = gw; }
    return false;
}
template <class ArgsT> __device__ __forceinline__ void cvt_range(const ArgsT& a, const int j0, const int n, LAS unsigned char* lds, int gw, int NGW, int wave, int lane) {
    LAS float* scr = (LAS float*)(lds + wave * 16384);
    int j = j0, it = gw; const int jend = j0 + n; CvtJob ja, jb; float wa[32], wb[32], ga = 1.0f, gb = 1.0f;
    bool va = cvt_next(a, j, jend, it, ja, gw); int ita = it, itb = 0; if (va) cvt_load(wa, ga, ja, ita, lane);
    while (va) {
        it += NGW; const bool vb = cvt_next(a, j, jend, it, jb, gw); itb = it; if (vb) cvt_load(wb, gb, jb, itb, lane);
        cvt_finish(wa, ga, ja, ita, scr, lane);
        if (!vb) break;
        it += NGW; va = cvt_next(a, j, jend, it, ja, gw); ita = it; if (va) cvt_load(wa, ga, ja, ita, lane);
        cvt_finish(wb, gb, jb, itb, scr, lane);
    }
}
__device__ __forceinline__ void zero_fill16(void* p, size_t bytes, int gtid, int gthreads) {
    u32x4* q = (u32x4*)p; const size_t n = bytes / 16; const u32x4 z = {0u, 0u, 0u, 0u};
    for (size_t i = gtid; i < n; i += gthreads) q[i] = z;
}
template <class ArgsT> __device__ __forceinline__ void prologue(const ArgsT& a, LAS unsigned char* lds, int vcu, int G, int wave, int lane, int tid) {
    unsigned char* ws = a.ws;
    LAS float* scr = (LAS float*)(lds + wave * 16384);
    const int gw = vcu * NWAVES + wave, NGW = G * NWAVES, gtid = gw * 64 + lane, gthreads = NGW * 64;
    cvt_range(a, 0, 2, lds, gw, NGW, wave, lane);
    for (int l = 0; l < 2; ++l) {
        zero_fill16(ws + WS_MLA + (size_t)l * MLA_B + (size_t)MLA_IN * DM * 2, (size_t)(MLA_IN_P - MLA_IN) * DM * 2, gtid, gthreads);
        for (int s = 0; s < 8; ++s) zero_fill16(ws + WS_NSA + (size_t)l * NSA_B + NSA_WQ_B + (size_t)s * GSL_B + (size_t)96 * 512 * 2, (size_t)160 * 512 * 2, gtid, gthreads); }
    { const int* pos = (const int*)a.in[I_POS]; float* ta = (float*)(ws + WS_TABA); float* tb = (float*)(ws + WS_TABB);
      for (int i = gtid; i < T * 32; i += gthreads) { const int t = i >> 5, f = i & 31; const float inv = powf(10000.0f, -(float)(2 * f) / 64.0f); const float ang = (float)pos[t] * inv;
          float sn, cs; sincosf(ang, &sn, &cs); ta[i] = cs; ta[T * 32 + i] = sn; }
      for (int i = gtid; i < T * 64; i += gthreads) { const int t = i >> 6, f = i & 63; const float inv = powf(10000.0f, -(float)(2 * f) / 128.0f); const float ang = (float)pos[t] * inv;
          float sn, cs; sincosf(ang, &sn, &cs); tb[i] = cs; tb[T * 64 + i] = sn; } }
    { const float* x = (const float*)a.in[I_X]; bf16* hb = (bf16*)(ws + WS_HB); float* ss0 = (float*)(ws + SS_OFF);
      for (int m = gw; m < T; m += NGW) { const f32x4* xr = (const f32x4*)(x + (size_t)m * DM) + lane; u32x2* o8 = (u32x2*)(hb + (size_t)m * DM) + lane; float s = 0.f;
#pragma unroll 4
          for (int j = 0; j < 16; ++j) { const f32x4 v = __builtin_nontemporal_load(&xr[64 * j]); s += pg8::quad_sq(v); u32x2 w; w.x = pk2(v[0], v[1]); w.y = pk2(v[2], v[3]); o8[64 * j] = w; }
          s = wave_sum(s, lane); if (lane == 0) ss0[(size_t)m * 64] = s; } }
}

constexpr float QS_MLA = 0.07216878364870322f * LOG2E;
constexpr float QS_NSA = 0.08838834764831845f * LOG2E;
__device__ __forceinline__ void unpack8(const u32x4 w, float (&v)[8]) {
    v[0] = __builtin_bit_cast(float, w.x << 16); v[1] = __builtin_bit_cast(float, w.x & 0xffff0000u); v[2] = __builtin_bit_cast(float, w.y << 16); v[3] = __builtin_bit_cast(float, w.y & 0xffff0000u);
    v[4] = __builtin_bit_cast(float, w.z << 16); v[5] = __builtin_bit_cast(float, w.z & 0xffff0000u); v[6] = __builtin_bit_cast(float, w.w << 16); v[7] = __builtin_bit_cast(float, w.w & 0xffff0000u);
}
__device__ __forceinline__ u32x4 pack8(const float (&v)[8]) { u32x4 w; w.x = cvt_pk_bf16(v[0], v[1]); w.y = cvt_pk_bf16(v[2], v[3]); w.z = cvt_pk_bf16(v[4], v[5]); w.w = cvt_pk_bf16(v[6], v[7]); return w; }
__device__ __forceinline__ void mla_k_finalize(const bf16* kvraw, const bf16* cbuf, const float* gk, const float* tabA, bf16* Kf, int gw, int NGW, int lane) {
    const int hd8 = lane >> 3, c = lane & 7;
    float g0[8], g1[8], g2[8];
#pragma unroll
    for (int i = 0; i < 8; ++i) { g0[i] = gk[c * 16 + i]; g1[i] = gk[c * 16 + 8 + i]; g2[i] = gk[128 + c * 8 + i]; }
    for (int it = gw; it < T * 4; it += NGW) { const int tok = it >> 2, head = (it & 3) * 8 + hd8;
        const bf16* kp = kvraw + (size_t)tok * 8192 + head * 256 + c * 16;
        const u32x4 w0 = *(const u32x4*)kp, w1 = *(const u32x4*)(kp + 8), wr = *(const u32x4*)(cbuf + (size_t)tok * MLA_IN_P + 1536 + c * 8);
        const f32x4 cs0 = *(const f32x4*)(tabA + tok * 32 + 8 * (c & 3)), cs1 = *(const f32x4*)(tabA + tok * 32 + 8 * (c & 3) + 4);
        const f32x4 sn0 = *(const f32x4*)(tabA + T * 32 + tok * 32 + 8 * (c & 3)), sn1 = *(const f32x4*)(tabA + T * 32 + tok * 32 + 8 * (c & 3) + 4);
        float a[8], bq[8], r8[8]; unpack8(w0, a); unpack8(w1, bq); unpack8(wr, r8);
        float ss = 0.f;
#pragma unroll
        for (int i = 0; i < 8; ++i) ss += a[i] * a[i] + bq[i] * bq[i] + r8[i] * r8[i];
        ss += shx(ss, 1, lane); ss += shx(ss, 2, lane); ss += shx(ss, 4, lane);
        const float r = __builtin_amdgcn_rsqf(ss * (1.0f / 192.0f) + EPS);
        float o[8];
#pragma unroll
        for (int i = 0; i < 8; ++i) { a[i] *= r * g0[i]; bq[i] *= r * g1[i]; r8[i] *= r * g2[i]; }
#pragma unroll
        for (int i = 0; i < 8; ++i) { const float p = shx(r8[i], 4, lane); const float cs = i < 4 ? cs0[i & 3] : cs1[i & 3], sn = i < 4 ? sn0[i & 3] : sn1[i & 3];
            o[i] = (c < 4) ? (r8[i] * cs - p * sn) : (r8[i] * cs + p * sn); }
        bf16* op = Kf + ((size_t)tok * 32 + head) * 192;
        *(u32x4*)(op + c * 16) = pack8(a); *(u32x4*)(op + c * 16 + 8) = pack8(bq); *(u32x4*)(op + 128 + c * 8) = pack8(o);
    }
}
__device__ __forceinline__ void ld16f(float (&x)[16], const float* p) {
#pragma unroll
    for (int q = 0; q < 4; ++q) { const f32x4 v = *(const f32x4*)(p + 4 * q); x[4 * q] = v[0]; x[4 * q + 1] = v[1]; x[4 * q + 2] = v[2]; x[4 * q + 3] = v[3]; } }
__device__ __forceinline__ void st16bf(bf16* p, const float (&x)[16]) {
    u32x4 a, c2; a.x = cvt_pk_bf16(x[0], x[1]); a.y = cvt_pk_bf16(x[2], x[3]); a.z = cvt_pk_bf16(x[4], x[5]); a.w = cvt_pk_bf16(x[6], x[7]);
    c2.x = cvt_pk_bf16(x[8], x[9]); c2.y = cvt_pk_bf16(x[10], x[11]); c2.z = cvt_pk_bf16(x[12], x[13]); c2.w = cvt_pk_bf16(x[14], x[15]);
    *(u32x4*)p = a; *(u32x4*)(p + 8) = c2; }
template <class ArgsT> __device__ __forceinline__ void nsa_kv_finalize(const ArgsT& a, int gw, int NGW, int lane) {
    unsigned char* ws = a.ws; const float* kvs = (const float*)(ws + WS_KVS); const float* tabB = (const float*)(ws + WS_TABB);
    bf16* Ks = (bf16*)(ws + WS_KSLC); bf16* Kw = (bf16*)(ws + WS_KWIN); bf16* Vs = (bf16*)(ws + WS_VSLC); bf16* Vw = (bf16*)(ws + WS_VWIN);
    const int v = lane >> 3, c = lane & 7, g = v & 3; const bool win = v >= 4;
    float gn[16]; ld16f(gn, (const float*)a.in[win ? I_GKW : I_GKS] + c * 16);
    for (int tok = gw; tok < T; tok += NGW) { const float* row = kvs + (size_t)tok * NKV; const size_t o = (size_t)tok * 512 + g * 128 + c * 16;
        const float* wp = (const float*)(ws + WS_ACT) + (size_t)tok * 1024 + g * 128 + c * 16;
        float x[16], cs[16], sn[16];
        if (win) { float x2[16]; ld16f(x, wp); ld16f(x2, wp + (size_t)T * 1024);
#pragma unroll
            for (int i = 0; i < 16; ++i) x[i] += x2[i]; }
        else ld16f(x, row + 2 * 512 + g * 128 + c * 16); ld16f(cs, tabB + tok * 64 + (c & 3) * 16); ld16f(sn, tabB + T * 64 + tok * 64 + (c & 3) * 16);
        float ss = 0.f;
#pragma unroll
        for (int i = 0; i < 16; ++i) ss += x[i] * x[i];
        ss += shx(ss, 1, lane); ss += shx(ss, 2, lane); ss += shx(ss, 4, lane);
        const float r = __builtin_amdgcn_rsqf(ss * (1.0f / 128.0f) + EPS);
#pragma unroll
        for (int i = 0; i < 16; ++i) { x[i] *= r * gn[i]; const float p = shx(x[i], 4, lane); x[i] = (c < 4) ? (x[i] * cs[i] - p * sn[i]) : (x[i] * cs[i] + p * sn[i]); }
        st16bf((win ? Kw : Ks) + o, x);
        float y[16];
        if (win) { float y2[16]; ld16f(y, wp + 512); ld16f(y2, wp + 512 + (size_t)T * 1024);
#pragma unroll
            for (int i = 0; i < 16; ++i) y[i] += y2[i]; }
        else ld16f(y, row + 3 * 512 + g * 128 + c * 16);
        st16bf((win ? Vw : Vs) + o, y);
    }
    bf16* bk = (bf16*)(ws + WS_BLKK); bf16* bv = (bf16*)(ws + WS_BLKV); const float* pk = (const float*)a.in[I_CPK]; const float* pv = (const float*)a.in[I_CPV];
    for (int rho = gw; rho < CMP_ROWS_P; rho += NGW) {
        if (rho < CMP_ROWS) { const int b = rho / (NCMP * NSA_G), rem = rho - b * (NCMP * NSA_G), n = rem >> 2, gg = rem & 3;
            for (int l0 = 0; l0 < 32; l0 += 8) { const int l = l0 + v; const float* row = kvs + (size_t)(b * SEQ + 16 * n + l) * NKV + gg * 128 + c * 16; const size_t o = (size_t)rho * 4096 + l * 128 + c * 16;
                float x[16], p[16]; ld16f(x, row); ld16f(p, pk + l * 128 + c * 16);
#pragma unroll
                for (int i = 0; i < 16; ++i) x[i] += p[i];
                st16bf(bk + o, x);
                ld16f(x, row + 512); ld16f(p, pv + l * 128 + c * 16);
#pragma unroll
                for (int i = 0; i < 16; ++i) x[i] += p[i];
                st16bf(bv + o, x); }
        } else { const u32x4 z = {0u, 0u, 0u, 0u}; for (int c8 = lane; c8 < 512; c8 += 64) { *(u32x4*)(bk + (size_t)rho * 4096 + c8 * 8) = z; *(u32x4*)(bv + (size_t)rho * 4096 + c8 * 8) = z; } }
    }
}
template <class ArgsT> __device__ __forceinline__ void nsa_cmp_out(const ArgsT& a, LAS unsigned char* lds, int gw, int NGW, int wave, int lane) {
    unsigned char* ws = a.ws; const float* P = (const float*)(ws + WS_KVS); bf16* Kc = (bf16*)(ws + WS_KC); bf16* Vc = (bf16*)(ws + WS_VC);
    const float* w2k = (const float*)a.in[I_CKW2]; const float* w2v = (const float*)a.in[I_CVW2]; const float* gkc = (const float*)a.in[I_GKC];
    const float* b1k = (const float*)a.in[I_CKB1]; const float* b1v = (const float*)a.in[I_CVB1];
    LAS float* hs = (LAS float*)(lds + wave * 4096);
    for (int rho = gw; rho < CMP_ROWS; rho += NGW) {
#pragma unroll
        for (int i = 0; i < 4; ++i) { const int j = lane + 64 * i; float sk = b1k[j], sv = b1v[j];
#pragma unroll
            for (int s = 0; s < 8; ++s) { sk += P[((size_t)s * CMP_ROWS_P + rho) * 256 + j]; sv += P[((size_t)(8 + s) * CMP_ROWS_P + rho) * 256 + j]; }
            hs[j] = pg8::silu_f(sk); hs[256 + j] = pg8::silu_f(sv); }
        LDS_WAIT(); asm volatile("" ::: "memory");
        float k0 = 0.f, k1 = 0.f, v0 = 0.f, v1 = 0.f;
#pragma unroll 8
        for (int j = 0; j < CMP_HID; ++j) { const float xk = hs[j], xv = hs[256 + j];
            k0 += xk * w2k[j * 128 + lane]; k1 += xk * w2k[j * 128 + 64 + lane]; v0 += xv * w2v[j * 128 + lane]; v1 += xv * w2v[j * 128 + 64 + lane]; }
        const float r = __builtin_amdgcn_rsqf(wave_sum(k0 * k0 + k1 * k1, lane) * (1.0f / 128.0f) + EPS);
        const int b = rho / (NCMP * NSA_G), rem = rho - b * (NCMP * NSA_G), n = rem >> 2, g = rem & 3; const size_t o = ((size_t)(b * 4 + g) * 128 + n) * 128;
        Kc[o + lane] = (bf16)f2bf(k0 * r * gkc[lane]); Kc[o + 64 + lane] = (bf16)f2bf(k1 * r * gkc[64 + lane]); Vc[o + lane] = (bf16)f2bf(v0); Vc[o + 64 + lane] = (bf16)f2bf(v1);
        LDS_WAIT(); asm volatile("" ::: "memory"); }
    for (int i = gw; i < 16; i += NGW) { const size_t o = ((size_t)i * 128 + 127) * 128; Kc[o + lane] = 0; Kc[o + 64 + lane] = 0; Vc[o + lane] = 0; Vc[o + 64 + lane] = 0; }
}
#ifndef MK_SENS
#define MK_SENS 0
#endif
struct AttnSt { f32x16 o[4]; float m, l; };
template <int DQK> struct ACfg { static constexpr int KSTR = DQK * 2 + 16, KBYTES = 64 * KSTR, VSTR = 320, VBYTES = 64 * VSTR, STAGE = KBYTES + VBYTES, NCK = DQK / 64, NSTEP = DQK / 16,
    KCH = KSTR / 16, VCH = VSTR / 16, NDMA = KCH + VCH  , NI = (NDMA + 7) / 8  ; };
typedef short v4i16_t __attribute__((ext_vector_type(4)));
__device__ __forceinline__ s16x4 vtr(const LAS unsigned char* p) { return __builtin_bit_cast(s16x4, __builtin_amdgcn_ds_read_tr16_b64_v4i16((LAS v4i16_t*)p)); }
__device__ __forceinline__ float xmax32(float x) { float a = x, c = x; asm volatile("s_nop 1\n\tv_permlane32_swap_b32 %0, %1" : "+v"(a), "+v"(c)); return fmaxf(a, c); }
__device__ __forceinline__ float xsum32(float x) { float a = x, c = x; asm volatile("s_nop 1\n\tv_permlane32_swap_b32 %0, %1" : "+v"(a), "+v"(c)); return a + c; }
typedef float f32x2_t __attribute__((ext_vector_type(2))); typedef __bf16 bf16x2_t __attribute__((ext_vector_type(2)));
__device__ __forceinline__ unsigned cvtpk(float lo, float hi) { const f32x2_t v = {lo, hi}; return __builtin_bit_cast(unsigned, __builtin_convertvector(v, bf16x2_t)); }
__device__ __forceinline__ int relane(int v) { asm volatile("" : "+v"(v)); return v; }
__device__ __forceinline__ void attn_init(AttnSt& st) {
#pragma unroll
    for (int d = 0; d < 4; ++d)
#pragma unroll
        for (int r = 0; r < 16; ++r) st.o[d][r] = 0.f;
    st.m = NEGF; st.l = 0.f;
}
template <int DQK> __device__ __forceinline__ void tile_offsets(unsigned (&off)[ACfg<DQK>::NI], unsigned krow, unsigned vrow, int wave, int lane) {
    using C = ACfg<DQK>;
#pragma unroll
    for (int j = 0; j < C::NI; ++j) { const int i = wave + 8 * j;
        if (i < C::KCH) { const int s = i * 64 + lane, r = s / C::KCH; int cc = s - r * C::KCH; cc = cc < DQK / 8 ? cc : 0; off[j] = (unsigned)r * krow * 2u + (unsigned)cc * 16u; }
        else { const int s = (i - C::KCH) * 64 + lane, r = (s / C::VCH) & 63; int cc = s % C::VCH; cc = cc < 16 ? cc : 0; off[j] = (unsigned)r * vrow * 2u + (unsigned)cc * 16u; } }
}
template <int DQK> __device__ __forceinline__ void tile_dma(LAS unsigned char* tb, const bf16* Kt, const bf16* Vt, const unsigned (&off)[ACfg<DQK>::NI], int wave) {
    using C = ACfg<DQK>;
#pragma unroll
    for (int j = 0; j < C::NI; ++j) { const int i = wave + 8 * j;
        if (i < C::KCH) __builtin_amdgcn_global_load_lds((const unsigned*)((const char*)Kt + off[j]), (LAS unsigned*)(tb + i * 1024), 16, 0, 0);
        else if (i < C::NDMA) __builtin_amdgcn_global_load_lds((const unsigned*)((const char*)Vt + off[j]), (LAS unsigned*)(tb + C::KBYTES + (i - C::KCH) * 1024), 16, 0, 0); }
}
#define DMA_WAIT_SYNC() do { asm volatile("s_waitcnt vmcnt(0)" ::: "memory"); __syncthreads(); } while (0)
template <int DQK> __device__ __forceinline__ void tile_scores(f32x16& s0, f32x16& s1, const bf16x8 (&qf)[DQK / 16], const LAS unsigned char* tb, const float c0  , int lane) {
    using C = ACfg<DQK>;
    const LAS unsigned char* kp = tb + (lane & 31) * C::KSTR + (lane >> 5) * 16;
#pragma unroll
    for (int r = 0; r < 16; ++r) { s0[r] = c0; s1[r] = c0; }
    bf16x8 kf[3][2];
    kf[0][0] = *(const LAS bf16x8*)(kp); kf[0][1] = *(const LAS bf16x8*)(kp + 32 * C::KSTR);
    kf[1][0] = *(const LAS bf16x8*)(kp + 32); kf[1][1] = *(const LAS bf16x8*)(kp + 32 * C::KSTR + 32);
    __builtin_amdgcn_sched_barrier(0);
#pragma unroll
    for (int st = 0; st < C::NSTEP; ++st) {
        if (st + 2 < C::NSTEP) { kf[(st + 2) % 3][0] = *(const LAS bf16x8*)(kp + (st + 2) * 32); kf[(st + 2) % 3][1] = *(const LAS bf16x8*)(kp + 32 * C::KSTR + (st + 2) * 32); }
        s0 = __builtin_amdgcn_mfma_f32_32x32x16_bf16(kf[st % 3][0], qf[st], s0, 0, 0, 0); s1 = __builtin_amdgcn_mfma_f32_32x32x16_bf16(kf[st % 3][1], qf[st], s1, 0, 0, 0);
        __builtin_amdgcn_sched_barrier(0); }
}
typedef float f32x2v __attribute__((ext_vector_type(2)));
__device__ __forceinline__ bf16x8 exp_pack8(const f32x16& s, int base, f32x2v& rs) {
    float e[8];
#pragma unroll
    for (int j = 0; j < 8; ++j) e[j] = __builtin_amdgcn_exp2f(s[base + j]);
#pragma unroll
    for (int j = 0; j < 4; ++j) rs += (f32x2v){e[2 * j], e[2 * j + 1]};
    u32x4 w; w.x = cvtpk(e[0], e[1]); w.y = cvtpk(e[2], e[3]); w.z = cvtpk(e[4], e[5]); w.w = cvtpk(e[6], e[7]);
    return __builtin_bit_cast(bf16x8, w);
}
template <int DQK> __device__ __forceinline__ void tile_compute(AttnSt& st, const bf16x8 (&qf)[DQK / 16], const LAS unsigned char* tb, int key0, int lo, int hi, int mode  , int lane) {
    using C = ACfg<DQK>; const int h = lane >> 5;
    const bool lane_off = (mode == 1) && (hi < 0);
    const bool fresh = (st.m == NEGF); const float ref = fresh ? 0.f : st.m;
    f32x16 s0, s1; tile_scores<DQK>(s0, s1, qf, tb, lane_off ? -3.0e38f : -ref, lane);
    float mx;
    if (mode == 2) {
#pragma unroll
        for (int r = 0; r < 16; ++r) { const int k0 = key0 + (r & 3) + 8 * (r >> 2) + 4 * h, k1 = k0 + 32;
            s0[r] = (k0 >= lo && k0 <= hi) ? s0[r] : NEGF; s1[r] = (k1 >= lo && k1 <= hi) ? s1[r] : NEGF; }
    }
    mx = fmaxf(s0[15], s1[15]);
#pragma unroll
    for (int r = 0; r < 15; ++r) asm("v_max3_f32 %0, %1, %2, %3" : "=v"(mx) : "v"(mx), "v"(s0[r]), "v"(s1[r]));
    mx = lane_off ? NEGF : mx;
    constexpr float RESCALE_THR = 8.0f;
    f32x2v rs = {0.f, 0.f};
    if (__builtin_amdgcn_ballot_w64(fresh ? (mx > 0.5f * NEGF) : (mx > RESCALE_THR)) != 0ull) {
        mx = xmax32(mx);
        const float mt = (mx > 0.5f * NEGF) ? mx + ref : NEGF, mn = fmaxf(st.m, mt), delta = (mn == NEGF || lane_off) ? 0.f : mn - ref;
        const float alpha = __builtin_amdgcn_exp2f(st.m - mn); st.l *= alpha;
#pragma unroll
        for (int d = 0; d < 4; ++d) st.o[d] = st.o[d] * alpha;
#pragma unroll
        for (int r = 0; r < 16; ++r) { s0[r] -= delta; s1[r] -= delta; }
        st.m = mn; }
    const LAS unsigned char* vp = tb + C::KBYTES + (4 * h + ((lane & 15) >> 2)) * C::VSTR + (((lane >> 4) & 1) * 16 + (lane & 3) * 4) * 2;
#define VFRAG(i) __builtin_shufflevector(vtr(vp + (16 * ((i) >> 2)) * C::VSTR + ((i) & 3) * 64), vtr(vp + (16 * ((i) >> 2) + 8) * C::VSTR + ((i) & 3) * 64), 0, 1, 2, 3, 4, 5, 6, 7)
    bf16x8 vf[4]; vf[0] = VFRAG(0); vf[1] = VFRAG(1); vf[2] = VFRAG(2);
    bf16x8 pb[2]; pb[0] = exp_pack8(s0, 0, rs);
    __builtin_amdgcn_sched_barrier(0);
#pragma unroll
    for (int ks = 0; ks < 4; ++ks) {
#pragma unroll
        for (int d = 0; d < 4; ++d) { const int i = 4 * ks + d;
            if (i + 3 < 16) vf[(i + 3) & 3] = VFRAG(i + 3);
            st.o[d] = __builtin_amdgcn_mfma_f32_32x32x16_bf16(vf[i & 3], pb[ks & 1], st.o[d], 0, 0, 0); }
#if MK_SENS == 1
        { const u32x4 zz = {0u, 0u, 0u, 0u}; const bf16x8 zf = __builtin_bit_cast(bf16x8, zz);
#pragma unroll
          for (int d = 0; d < 4; ++d) st.o[d] = __builtin_amdgcn_mfma_f32_32x32x16_bf16(vf[d], zf, st.o[d], 0, 0, 0); }
#endif
        __builtin_amdgcn_sched_barrier(0);
        if (ks < 3) { pb[(ks + 1) & 1] = exp_pack8(ks + 1 < 2 ? s0 : s1, 8 * ((ks + 1) & 1), rs); __builtin_amdgcn_sched_barrier(0); } }
#undef VFRAG
#if MK_SENS == 2
#pragma unroll
    for (int r = 0; r < 16; ++r) rs.x += __builtin_amdgcn_exp2f(s0[r] - 1000.f) + __builtin_amdgcn_exp2f(s1[r] - 1000.f);
#endif
    st.l += xsum32(rs.x + rs.y);
}
template <int DQK> __device__ __forceinline__ void attn_pass(AttnSt& st, const bf16x8 (&qf)[DQK / 16], LAS unsigned char* lds, const bf16* Kg, unsigned krow, const bf16* Vg, unsigned vrow,
                                                         unsigned tilemask, unsigned selbits, unsigned selall, int lo, int hi, int wlo, int whi, int ilo, int ihi, int tid, int lane) {
    using C = ACfg<DQK>;
    unsigned rem = (unsigned)__builtin_amdgcn_readfirstlane((int)tilemask); if (rem == 0u) return;
    int kt = __builtin_ctz(rem); rem &= rem - 1u;
    unsigned off[C::NI]; const int wave = __builtin_amdgcn_readfirstlane(tid >> 6); tile_offsets<DQK>(off, krow, vrow, wave, lane);
    tile_dma<DQK>(lds, Kg + (size_t)kt * 64 * krow, Vg + (size_t)kt * 64 * vrow, off, wave);
    DMA_WAIT_SYNC();
    int buf = 0;
    for (;;) {
        const bool more = rem != 0u; int ktn = 0;
        if (more) { ktn = __builtin_ctz(rem); rem &= rem - 1u; tile_dma<DQK>(lds + (buf ^ 1) * C::STAGE, Kg + (size_t)ktn * 64 * krow, Vg + (size_t)ktn * 64 * vrow, off, wave); }
        if (kt * 64 <= whi && kt * 64 + 63 >= wlo) tile_compute<DQK>(st, qf, lds + buf * C::STAGE, kt * 64, lo, ((selbits >> kt) & 1u) ? hi : -1, (kt * 64 >= ilo && kt * 64 + 63 <= ihi) ? (((selall >> kt) & 1u) ? 0 : 1) : 2, lane);
        DMA_WAIT_SYNC();
        if (!more) break;
        kt = ktn; buf ^= 1;
    }
}

__device__ __forceinline__ float sumsq8(const u32x4 w) { float v[8]; unpack8(w, v); return ((v[0] * v[0] + v[1] * v[1]) + (v[2] * v[2] + v[3] * v[3])) + ((v[4] * v[4] + v[5] * v[5]) + (v[6] * v[6] + v[7] * v[7])); }
__device__ __forceinline__ void scaled8(float (&v)[8], const u32x4 w, float r, const float* g) { unpack8(w, v); const f32x4 ga = *(const f32x4*)g, gb = *(const f32x4*)(g + 4);
#pragma unroll
    for (int j = 0; j < 8; ++j) v[j] *= r * (j < 4 ? ga[j & 3] : gb[j & 3]); }
__device__ __forceinline__ void rope8(float (&x1)[8], float (&x2)[8], const float* cs_p, const float* sn_p) { const f32x4 ca = *(const f32x4*)cs_p, cb = *(const f32x4*)(cs_p + 4), sa = *(const f32x4*)sn_p, sb = *(const f32x4*)(sn_p + 4);
#pragma unroll
    for (int j = 0; j < 8; ++j) { const float cs = j < 4 ? ca[j & 3] : cb[j & 3], sn = j < 4 ? sa[j & 3] : sb[j & 3], a = x1[j], b2 = x2[j]; x1[j] = a * cs - b2 * sn; x2[j] = b2 * cs + a * sn; } }
__device__ __forceinline__ bf16x8 packs8(float (&v)[8], float sc) {
#pragma unroll
    for (int j = 0; j < 8; ++j) v[j] *= sc;
    return __builtin_bit_cast(bf16x8, pack8(v)); }
__device__ __forceinline__ void mla_load_q(bf16x8 (&qf)[12], const bf16* qrow, const float* gq, const float* tabA_row, int h, int lane) {
    u32x4 w[12]; float ss = 0.f;
#pragma unroll
    for (int s = 0; s < 12; ++s) { w[s] = *(const u32x4*)(qrow + 16 * s + 8 * h); ss += sumsq8(w[s]); }
    ss += shx(ss, 32, lane); const float r = __builtin_amdgcn_rsqf(ss * (1.0f / 192.0f) + EPS);
#pragma unroll
    for (int s = 0; s < 8; ++s) { float v[8]; scaled8(v, w[s], r, gq + 16 * s + 8 * h); qf[s] = packs8(v, QS_MLA); }
#pragma unroll
    for (int s = 8; s < 10; ++s) { float x1[8], x2[8]; scaled8(x1, w[s], r, gq + 16 * s + 8 * h); scaled8(x2, w[s + 2], r, gq + 16 * (s + 2) + 8 * h);
        const int i0 = 16 * (s - 8) + 8 * h; rope8(x1, x2, tabA_row + i0, tabA_row + T * 32 + i0); qf[s] = packs8(x1, QS_MLA); qf[s + 2] = packs8(x2, QS_MLA); }
}
template <bool ROPE> __device__ __forceinline__ void nsa_load_q(bf16x8 (&qf)[8], const bf16* qrow, const float* gq, const float* tabB_row, int h, int lane) {
    u32x4 w[8]; float ss = 0.f;
#pragma unroll
    for (int s = 0; s < 8; ++s) { w[s] = *(const u32x4*)(qrow + 16 * s + 8 * h); ss += sumsq8(w[s]); }
    ss += shx(ss, 32, lane); const float r = __builtin_amdgcn_rsqf(ss * (1.0f / 128.0f) + EPS);
#pragma unroll
    for (int s = 0; s < 4; ++s) { float x1[8], x2[8]; scaled8(x1, w[s], r, gq + 16 * s + 8 * h); scaled8(x2, w[s + 4], r, gq + 16 * (s + 4) + 8 * h);
        if (ROPE) { const int i0 = 16 * s + 8 * h; rope8(x1, x2, tabB_row + i0, tabB_row + T * 64 + i0); }
        qf[s] = packs8(x1, QS_NSA); qf[s + 4] = packs8(x2, QS_NSA); }
}

template <bool RMW> __device__ __forceinline__ void attn_out16(const AttnSt& st, float sc, bf16* rowp  , int h) {
#pragma unroll
    for (int d = 0; d < 4; ++d)
#pragma unroll
        for (int k = 0; k < 2; ++k) { float e[4], o[4];
#pragma unroll
            for (int i = 0; i < 4; ++i) { e[i] = st.o[d][8 * k + i] * sc; o[i] = st.o[d][8 * k + 4 + i] * sc; asm volatile("s_nop 1\n\tv_permlane32_swap_b32 %0, %1" : "+v"(e[i]), "+v"(o[i])); }
            bf16* p = rowp + 32 * d + 8 * (2 * k + h);
            if (RMW) { float v[8]; unpack8(*(const u32x4*)p, v);
#pragma unroll
                for (int i = 0; i < 4; ++i) { e[i] += v[i]; o[i] += v[4 + i]; } }
            u32x4 w; w.x = cvt_pk_bf16(e[0], e[1]); w.y = cvt_pk_bf16(e[2], e[3]); w.z = cvt_pk_bf16(o[0], o[1]); w.w = cvt_pk_bf16(o[2], o[3]);
            *(u32x4*)p = w; }
}

__device__ __forceinline__ void mla_attn_unit(int b, int hd, int qb, const bf16* Qraw, const float* gq, const float* tabA, const bf16* Kf, const bf16* KVraw, bf16* OB, LAS unsigned char* lds, int tid, int lane, int wave) {
    const int r32 = lane & 31, h = lane >> 5, q = qb * 256 + wave * 32 + r32; const size_t tok = (size_t)b * SEQ + q;
    bf16x8 qf[12]; mla_load_q(qf, Qraw + tok * 6144 + hd * 192, gq, tabA + tok * 32, h, lane);
    AttnSt st; attn_init(st);
    const int ntiles = 4 * qb + 4; const unsigned tilemask = ntiles >= 32 ? 0xffffffffu : ((1u << ntiles) - 1u);
    attn_pass<192>(st, qf, lds, Kf + ((size_t)b * SEQ * 32 + hd) * 192, 32u * 192u, KVraw + (size_t)b * SEQ * 8192 + hd * 256 + 128, 8192u,
                   tilemask, 0xffffffffu, 0xffffffffu, 0, q, 0, qb * 256 + wave * 32 + 31, 0, qb * 256 + wave * 32, tid, lane);
    const int l2 = relane(lane); const size_t tok2 = (size_t)b * SEQ + qb * 256 + wave * 32 + (l2 & 31);
    attn_out16<false>(st, 1.0f / st.l, OB + tok2 * DM + hd * 128, l2 >> 5);
}

__device__ __forceinline__ f32x4 ld4bf(const bf16* p) { const u32x2 w = *(const u32x2*)p; return (f32x4){__builtin_bit_cast(float, w.x << 16), __builtin_bit_cast(float, w.x & 0xffff0000u), __builtin_bit_cast(float, w.y << 16), __builtin_bit_cast(float, w.y & 0xffff0000u)}; }
__device__ __forceinline__ void st4bf(bf16* p, float a, float b, float c, float d) { u32x2 w; w.x = cvt_pk_bf16(a, b); w.y = cvt_pk_bf16(c, d); *(u32x2*)p = w; }
constexpr int IMP_OFF = 2 * ACfg<128>::STAGE, IMP_SLICE = 32 * 33 * 4, IMP2_OFF = IMP_OFF + NWAVES * IMP_SLICE;
static_assert(IMP2_OFF + 32 * 36 * 4 <= RING_BYTES && 2 * ACfg<192>::STAGE <= RING_BYTES, "attention LDS");
__device__ __forceinline__ void nsa_cmp_unit(int b, int g, int tt, const bf16* Qraw, const float* gq, const bf16* Kc, const bf16* Vc, const float* GP, const float* bgate, float* gates, bf16* oacc, unsigned* SEL, LAS unsigned char* lds, int tid, int lane, int wave) {
    const int r32 = lane & 31, h = lane >> 5, t0 = tt * 32, t = t0 + r32, head = g * 8 + wave; const size_t tok = (size_t)b * SEQ + t;
    bf16x8 qf[8]; nsa_load_q<false>(qf, Qraw + tok * 4096 + head * 128, gq, nullptr, h, lane);
    const int nvalid = t >= 31 ? ((t - 31) >> 4) + 1 : 0;
    AttnSt st; attn_init(st);
    const bf16* Kg = Kc + (size_t)(b * 4 + g) * 128 * 128; const bf16* Vg = Vc + (size_t)(b * 4 + g) * 128 * 128;
    LAS float* imp = (LAS float*)(lds + IMP_OFF + wave * IMP_SLICE); LAS float* imp2 = (LAS float*)(lds + IMP2_OFF);
    attn_pass<128>(st, qf, lds, Kg, 128u, Vg, 128u, 3u, 0xffffffffu, 0xffffffffu, 0, nvalid - 1, 0, t0 >> 4, 0, (t0 >= 31 ? ((t0 - 31) >> 4) : -1), tid, lane);
    const float invl = nvalid > 0 ? 1.0f / st.l : 0.f;
    { const int l2 = relane(lane); const size_t tok2 = (size_t)b * SEQ + t0 + (l2 & 31);
      float g3[3];
      { struct F3 { float x, y, z; }; float s0g = bgate[head * 3], s1g = bgate[head * 3 + 1], s2g = bgate[head * 3 + 2];
#pragma unroll
        for (int ks = 0; ks < 8; ++ks) { const F3 v = *(const F3*)(GP + ((size_t)ks * T + tok2) * 96 + head * 3); s0g += v.x; s1g += v.y; s2g += v.z; }
        g3[0] = pg8::sigmoid_f(s0g); g3[1] = pg8::sigmoid_f(s1g); g3[2] = pg8::sigmoid_f(s2g); }
      if ((l2 >> 5) == 0) { gates[tok2 * 96 + head * 3 + 0] = g3[0]; gates[tok2 * 96 + head * 3 + 1] = g3[1]; gates[tok2 * 96 + head * 3 + 2] = g3[2]; }
      attn_out16<false>(st, invl * g3[0], oacc + tok2 * 4096 + head * 128, l2 >> 5); }
    { float Bv[16];
#pragma unroll
      for (int tl = 0; tl < 2; ++tl) { f32x16 s0, s1; tile_scores<128>(s0, s1, qf, lds + tl * ACfg<128>::STAGE, 0.f, lane);
#pragma unroll
          for (int kb = 0; kb < 2; ++kb)
#pragma unroll
              for (int gq = 0; gq < 4; ++gq) { float P[4];
#pragma unroll
                  for (int i = 0; i < 4; ++i) { const int n = 64 * tl + 32 * kb + 8 * gq + 4 * h + i; const float sv = kb ? s1[4 * gq + i] : s0[4 * gq + i]; P[i] = (n < nvalid) ? __builtin_amdgcn_exp2f(sv - st.m) * invl : 0.f; }
                  const int jp = 16 * tl + 8 * kb + 2 * gq + h;
                  imp[r32 * 33 + jp] = 2.0f * (P[0] + P[1] + P[2]) + P[3]; Bv[tl * 8 + kb * 4 + gq] = P[3]; } }
      LDS_WAIT(); asm volatile("" ::: "memory");
#pragma unroll
      for (int tl = 0; tl < 2; ++tl)
#pragma unroll
          for (int kb = 0; kb < 2; ++kb)
#pragma unroll
              for (int gq = 0; gq < 4; ++gq) { const int jp = 16 * tl + 8 * kb + 2 * gq + h; imp[r32 * 33 + jp + 1] += Bv[tl * 8 + kb * 4 + gq]; } }
    __syncthreads();
    { const int tl = tid >> 4, jj = (tid & 15) * 2, tq = t0 + tl, cur = tq >> 6; float mine[2]; bool valid[2];
#pragma unroll
      for (int e = 0; e < 2; ++e) { const int j = jj + e; const bool forced = (j == 0) || (j == cur) || (j == cur - 1); valid[e] = j <= cur;
          float sum = 0.f;
#pragma unroll
          for (int w = 0; w < NWAVES; ++w) sum += ((const LAS float*)(lds + IMP_OFF + w * IMP_SLICE))[tl * 33 + j];
          mine[e] = forced ? 1e6f : (valid[e] ? sum : -1.0f); imp2[tl * 36 + j] = mine[e]; }
      __syncthreads();
      unsigned bits = 0u;
      int cnt0 = 0, cnt1 = 0;
#pragma unroll
      for (int i4 = 0; i4 < 8; ++i4) { const f32x4 xv = *(const LAS f32x4*)(imp2 + tl * 36 + 4 * i4);
#pragma unroll
          for (int q = 0; q < 4; ++q) { const int i = 4 * i4 + q; const float x = xv[q];
              cnt0 += (x > mine[0] || (x == mine[0] && i < jj)) ? 1 : 0; cnt1 += (x > mine[1] || (x == mine[1] && i < jj + 1)) ? 1 : 0; } }
      if (cnt0 < 16 && valid[0]) bits |= 1u << jj;
      if (cnt1 < 16 && valid[1]) bits |= 1u << (jj + 1);
      bits |= shxu(bits, 1, lane); bits |= shxu(bits, 2, lane); bits |= shxu(bits, 4, lane); bits |= shxu(bits, 8, lane);
      if ((tid & 15) == 0) SEL[(size_t)(b * 4 + g) * SEQ + tq] = bits;
      __syncthreads(); }
}

__device__ __forceinline__ void nsa_sw_unit(int b, int g, int tt, const bf16* Qraw, const float* gq, const float* tabB, const bf16* Ks, const bf16* Vs, const bf16* Kw, const bf16* Vw, const float* gates, const unsigned* SEL, bf16* OB,
                                            LAS unsigned char* lds, int tid, int lane, int wave) {
    const int r32 = lane & 31, h = lane >> 5, t0 = tt * 32, t = t0 + r32, head = g * 8 + wave; const size_t tok = (size_t)b * SEQ + t;
    bf16x8 qf[8]; nsa_load_q<true>(qf, Qraw + tok * 4096 + head * 128, gq, tabB + tok * 64, h, lane);
    const unsigned sel = SEL[(size_t)(b * 4 + g) * SEQ + t]; unsigned uni = sel, all = sel;
#pragma unroll
    for (int o = 1; o < 64; o <<= 1) { uni |= shxu(uni, o, lane); all &= shxu(all, o, lane); }
    all = (unsigned)__builtin_amdgcn_readfirstlane((int)all);
    const int cur = t0 >> 6; const unsigned causal_tiles = cur >= 31 ? 0xffffffffu : ((2u << cur) - 1u);
    const size_t kvoff = (size_t)b * SEQ * 512 + g * 128;
    AttnSt st; attn_init(st);
    attn_pass<128>(st, qf, lds, Ks + kvoff, 512u, Vs + kvoff, 512u, uni & causal_tiles, sel, all, 0, t, 0, t0 + 31, 0, t0, tid, lane);
    { const int l2 = relane(lane); const size_t tok2 = (size_t)b * SEQ + t0 + (l2 & 31);
      attn_out16<true>(st, gates[tok2 * 96 + head * 3 + 1] / st.l, OB + tok2 * DM + head * 128, l2 >> 5); }
    attn_init(st);
    const int wlo = t0 - 511 > 0 ? t0 - 511 : 0, whi = t0 + 31, ktl = wlo >> 6, kth = whi >> 6;
    const unsigned wmask = (kth >= 31 ? 0xffffffffu : ((2u << kth) - 1u)) & ~((1u << ktl) - 1u);
    attn_pass<128>(st, qf, lds, Kw + kvoff, 512u, Vw + kvoff, 512u, wmask, 0xffffffffu, 0xffffffffu, t - 511 > 0 ? t - 511 : 0, t, wlo, whi, (t0 + 31 - 511 > 0 ? t0 + 31 - 511 : 0), t0, tid, lane);
    { const int l2 = relane(lane); const size_t tok2 = (size_t)b * SEQ + t0 + (l2 & 31);
      attn_out16<true>(st, gates[tok2 * 96 + head * 3 + 2] / st.l, OB + tok2 * DM + head * 128, l2 >> 5); }
}
constexpr int N_PHASES = 1 + 2 * 9 + 2 * 8 + 4;
#ifndef MK_MULTI
#define MK_MULTI 0
#endif
__device__ __forceinline__ int lane_id_asm() { int l; asm volatile("v_mbcnt_lo_u32_b32 %0, -1, 0\n\tv_mbcnt_hi_u32_b32 %0, -1, %0" : "=v"(l)); return l; }
__device__ __forceinline__ int opq_v(int v) { asm volatile("" : "+v"(v)); return v; }
__device__ __forceinline__ int opq_s(int v) { asm volatile("" : "+s"(v)); return v; }
#define CAS __attribute__((address_space(4)))
typedef const CAS Args* ArgsP;
__device__ __forceinline__ ArgsP opq_args() { ArgsP p = (ArgsP)__builtin_amdgcn_kernarg_segment_ptr(); asm volatile("" : "+s"(p)); return p; }
__global__ void __launch_bounds__(NTHREADS, 2) trunk_fwd(Args args_k) {
    extern __shared__ __attribute__((aligned(16))) unsigned char lds_raw[];
    LAS unsigned char* lds = (LAS unsigned char*)lds_raw;
    volatile LAS unsigned* MISC = (volatile LAS unsigned*)(lds + MISC_OFF);
    for (int u = threadIdx.x; u < (LDS_BYTES - LDSCTL_OFF) / 4; u += NTHREADS) ((LAS unsigned*)(lds + LDSCTL_OFF))[u] = 0u;
    __syncthreads();
    const int lo = args_k.ph_lo, hi = args_k.ph_hi, wave_k = __builtin_amdgcn_readfirstlane((int)threadIdx.x >> 6);
    XcdBarrier bar; bar.bar = (unsigned*)(args_k.ws + WS_CTL) + CW_BAR; bar.x = 0; bar.st = nullptr;
    if (hi - lo > 1) bar = xcd_barrier_post((unsigned*)(args_k.ws + WS_CTL) + CW_BAR, MISC + 8);
#ifndef MK_PROBE
#define MK_PROBE 0
#endif
#define REP(k) for (int rep_ = 0; rep_ < ((MK_PROBE == (k)) ? 2 : 1); ++rep_)
    int ph = 0, layer_i = 0, sub_i = 0;
#define PH_BEGIN if (ph >= lo && ph < hi) { asm volatile("; PHMARK %0" :: "i"(__LINE__)); const CAS Args& args = *opq_args(); const int layer = opq_s(layer_i), sub = opq_s(sub_i); (void)layer; (void)sub; const int wave = opq_s(wave_k), lane = lane_id_asm(), tid = wave * 64 + lane; \
    const int G = opq_s((int)gridDim.x), bx = opq_s((int)blockIdx.x), vcu = (G % 8 == 0) ? (bx % 8) * (G / 8) + bx / 8 : bx, gw = vcu * NWAVES + wave, NGW = G * NWAVES; (void)lane; (void)gw; (void)NGW; (void)vcu; unsigned char* ws = args.ws; float* ssb = (float*)(ws + SS_OFF); constexpr size_t SSL = (size_t)T * 64; \
    bf16* HB = (bf16*)(ws + WS_HB); bf16* ACT = (bf16*)(ws + WS_ACT); bf16* CBUF = (bf16*)(ws + WS_CBUF); bf16* QRAW = (bf16*)(ws + WS_QRAW); bf16* KVRAW = (bf16*)(ws + WS_KVRAW); \
    bf16* QF = (bf16*)(ws + WS_QF); bf16* KF = (bf16*)(ws + WS_KF); bf16* OB = (bf16*)(ws + WS_OB); float* GATES = (float*)(ws + WS_GATES); unsigned* SEL = (unsigned*)(ws + WS_SEL); \
    float* OACC = (float*)(ws + WS_KVRAW); float* KVS = (float*)(ws + WS_KVS); (void)ssb; (void)HB; (void)ACT; (void)CBUF; (void)QRAW; (void)KVRAW; (void)QF; (void)KF; (void)OB; (void)GATES; (void)SEL; (void)OACC; (void)KVS;
#ifndef MK_BAR2
#define MK_BAR2 0
#endif
#define PH_END if (ph + 1 < hi) { xcd_barrier(bar); if (MK_BAR2) xcd_barrier(bar); } } ++ph;
#define RS_FILL(ssptr, nparts_, invdim_, M_, N_, cidx) pg8::RsTab rt_; { pg8::StaticOrder S0_; S0_.init((M_), (N_), G, (cidx)); pg8::Unit u0_; rt_.tab = (const LAS float*)(lds + RSTAB_OFF); rt_.pm = -1; \
        if (S0_.next(0, u0_)) { rt_.pm = u0_.pm; pg8::rs_table_fill((LAS float*)(lds + RSTAB_OFF), (ssptr), (nparts_), (invdim_), u0_.pm, tid, lane); } }
#define RUN_GEMM(EPI_T, E, Aptr, lda_, Bptr, M_, N_, K_, cidx) do { const pg8::Gemm g_{(const pg8::bf16_t*)(Aptr), (const pg8::bf16_t*)(Bptr), (M_), (N_), (K_), (lda_)}; pg8::StaticOrder S_; S_.init((M_), (N_), G, (cidx)); \
        pg8::gemm_phase<EPI_T, pg8::StaticOrder, EPI_T::ALIGN, true>(lds, g_, S_, (E), opq_v(tid)); } while (0)

    REP(1) {
    PH_BEGIN prologue(args, lds, vcu, G, wave, lane, tid); PH_END
    }

    for (layer_i = 0; layer_i < DEPTH; ++layer_i) {
        for (sub_i = 0; sub_i < 3; ++sub_i) {
            if (sub_i != 1) {
                REP(2) {
                PH_BEGIN { const int which = sub >> 1; unsigned char* wgu = ws + WS_FFN + (size_t)(layer * 2 + which) * FFN_B; const float* ssp = ssb + (size_t)(3 * layer + sub) * SSL; const int np = (layer == 0 && sub == 0) ? 1 : 64; RS_FILL(ssp, np, 1.0f / DM, T, 2 * FF, bx)
                    const pg8::EpiSwiGLU E{ACT, FF, ssp, np, 1.0f / DM, rt_}; RUN_GEMM(pg8::EpiSwiGLU, E, HB, DM, wgu, T, 2 * FF, DM, bx); cvt_range(args, 6 * layer + 3 * which + 2, 1, lds, gw, NGW, wave, lane); } PH_END
                }
                PH_BEGIN { const int which = sub >> 1; unsigned char* wgu = ws + WS_FFN + (size_t)(layer * 2 + which) * FFN_B; const bool last = (layer == DEPTH - 1 && sub == 2), first = (layer == 0 && sub == 0);
                    const pg8::EpiResid E{first ? (const float*)args.in[I_X] : nullptr, HB, last ? args.out : nullptr, last ? nullptr : ssb + (size_t)(3 * layer + sub + 1) * SSL, 0.5f, DM}; RUN_GEMM(pg8::EpiResid, E, ACT, FF, wgu + FFN_GU_B, T, DM, FF, bx);
                    if (sub == 0) cvt_range(args, layer < 2 ? 24 + 4 * layer : 32 + 3 * (layer - 2), layer < 2 ? 1 : 2, lds, gw, NGW, wave, lane);
                    else if (layer < DEPTH - 1) { if (layer == 1) cvt_range(args, 38, 4, lds, gw, NGW, wave, lane); else cvt_range(args, 6 * (layer + 1), 2, lds, gw, NGW, wave, lane); } } PH_END
#if MK_PROBE == 7
                PH_BEGIN { const int which = sub >> 1; unsigned char* wgu = ws + WS_FFN + (size_t)(layer * 2 + which) * FFN_B;
                    const pg8::EpiResid E{(const float*)args.in[I_X], (pg8::bf16_t*)(ws + WS_QF), nullptr, nullptr, 0.5f, DM}; RUN_GEMM(pg8::EpiResid, E, ACT, FF, wgu + FFN_GU_B, T, DM, FF, bx); } PH_END
#endif
            } else if (layer_i < 2) {
#define MLA_PTRS unsigned char* wm = ws + WS_MLA + (size_t)layer * MLA_B; float* sscq = ssb + (size_t)(SS_CQ + layer) * SSL; float* ssckv = ssb + (size_t)(SS_CKV + layer) * SSL; (void)wm; (void)sscq; (void)ssckv;
                REP(5) {
                PH_BEGIN { MLA_PTRS RS_FILL(ssb + (size_t)(3 * layer + 1) * SSL, 64, 1.0f / DM, T, MLA_IN_P, bx) const pg8::EpiScaleBf16 E{CBUF, MLA_IN_P, ssb + (size_t)(3 * layer + 1) * SSL, 64, 1.0f / DM, sscq, ssckv, 4, 6, rt_}; RUN_GEMM(pg8::EpiScaleBf16, E, HB, DM, wm, T, MLA_IN_P, DM, bx);
                           constexpr int NU_ = (T / 256) * (MLA_IN_P / 256);
                           if (G > NU_) { if (bx >= NU_) cvt_range(args, 25 + 4 * layer, 2, lds, (bx - NU_) * NWAVES + wave, (G - NU_) * NWAVES, wave, lane); } else cvt_range(args, 25 + 4 * layer, 2, lds, gw, NGW, wave, lane); } PH_END
                PH_BEGIN { MLA_PTRS { RS_FILL(sscq, 16, 1.0f / QLORA, T, 6144, bx) const pg8::EpiScaleBf16 E1{QRAW, 6144, sscq, 16, 1.0f / QLORA, nullptr, nullptr, 0, 0, rt_}; RUN_GEMM(pg8::EpiScaleBf16, E1, CBUF, MLA_IN_P, wm + MLA_WIN_B, T, 6144, QLORA, bx); }
                           RS_FILL(ssckv, 8, 1.0f / KVLORA, T, 8192, bx) const pg8::EpiScaleBf16 E2{KVRAW, 8192, ssckv, 8, 1.0f / KVLORA, nullptr, nullptr, 0, 0, rt_}; RUN_GEMM(pg8::EpiScaleBf16, E2, CBUF + QLORA, MLA_IN_P, wm + MLA_WIN_B + MLA_WUQ_B, T, 8192, KVLORA, bx); } PH_END
                }
                REP(3) {
                PH_BEGIN mla_k_finalize(KVRAW, CBUF, (const float*)args.in[I_MGK] + layer * MLA_QK, (const float*)(ws + WS_TABA), KF, gw, NGW, lane); PH_END
                PH_BEGIN for (int u = vcu; u < 512; u += G) { const int bh = u >> 2, pi = u & 3;
                             const float* gq = (const float*)args.in[I_MGQ] + layer * MLA_QK; const float* tabA = (const float*)(ws + WS_TABA);
                             mla_attn_unit(bh >> 5, bh & 31, 7 - pi, QRAW, gq, tabA, KF, KVRAW, OB, lds, tid, lane, wave); mla_attn_unit(bh >> 5, bh & 31, pi, QRAW, gq, tabA, KF, KVRAW, OB, lds, tid, lane, wave); }
                         __syncthreads(); cvt_range(args, 27 + 4 * layer, 1, lds, gw, NGW, wave, lane); PH_END
                }
                PH_BEGIN { MLA_PTRS const pg8::EpiResid E{nullptr, HB, nullptr, ssb + (size_t)(3 * layer + 2) * SSL, 1.0f, DM}; RUN_GEMM(pg8::EpiResid, E, OB, DM, wm + MLA_WIN_B + MLA_WUQ_B + MLA_WUKV_B, T, DM, DM, bx); cvt_range(args, 6 * layer + 3, 2, lds, gw, NGW, wave, lane); } PH_END
#if MK_PROBE == 9
                PH_BEGIN { MLA_PTRS const pg8::EpiResid E{(const float*)args.in[I_X], (pg8::bf16_t*)(ws + WS_QF), nullptr, nullptr, 1.0f, DM}; RUN_GEMM(pg8::EpiResid, E, OB, DM, wm + MLA_WIN_B + MLA_WUQ_B + MLA_WUKV_B, T, DM, DM, bx); } PH_END
#endif
            } else {
#define NSA_PTRS const int bl = layer - 2; unsigned char* wn = ws + WS_NSA + (size_t)bl * NSA_B;
                REP(8) PH_BEGIN { NSA_PTRS const float* ssm = ssb + (size_t)(3 * layer + 1) * SSL;
                    { RS_FILL(ssm, 64, 1.0f / DM, T, 4096, bx) const pg8::EpiScaleBf16 E{QRAW, 4096, ssm, 64, 1.0f / DM, nullptr, nullptr, 0, 0, rt_}; RUN_GEMM(pg8::EpiScaleBf16, E, HB, DM, wn, T, 4096, DM, bx); }
                    for (int uid = bx; uid < 256; uid += G) { const int ks = uid >> 5, c2 = uid & 31; RS_FILL(ssm, 64, 1.0f / DM, T, 256, c2)
                        const pg8::EpiGateP E2{(float*)(ws + WS_GP) + (size_t)ks * T * 96, ssm, 64, 1.0f / DM, rt_};
                        const pg8::Gemm g2{(const pg8::bf16_t*)(HB + ks * 512), (const pg8::bf16_t*)(wn + NSA_WQ_B + (size_t)ks * GSL_B), T, 256, 512, DM}; pg8::StaticOrder S2; S2.init(T, 256, 32, c2);
                        pg8::gemm_phase<pg8::EpiGateP, pg8::StaticOrder, true, true>(lds, g2, S2, E2, opq_v(tid)); } } PH_END
                REP(4) {
                PH_BEGIN for (int u = vcu; u < 512; u += G) { const int bg = u >> 5, pi = u & 31;
                             nsa_cmp_unit(bg >> 2, bg & 3, 63 - pi, QRAW, (const float*)args.in[I_NGQ] + (layer - 2) * DH, (const bf16*)(ws + WS_KC), (const bf16*)(ws + WS_VC), (const float*)(ws + WS_GP), (const float*)args.in[I_NBG] + (layer - 2) * 96, GATES, OB, SEL, lds, tid, lane, wave);
                             nsa_cmp_unit(bg >> 2, bg & 3, pi, QRAW, (const float*)args.in[I_NGQ] + (layer - 2) * DH, (const bf16*)(ws + WS_KC), (const bf16*)(ws + WS_VC), (const float*)(ws + WS_GP), (const float*)args.in[I_NBG] + (layer - 2) * 96, GATES, OB, SEL, lds, tid, lane, wave); } PH_END
                PH_BEGIN for (int u = vcu; u < 512; u += G) { const int bg = u >> 5, pi = u & 31;
                             nsa_sw_unit(bg >> 2, bg & 3, 63 - pi, QRAW, (const float*)args.in[I_NGQ] + (layer - 2) * DH, (const float*)(ws + WS_TABB), (const bf16*)(ws + WS_KSLC), (const bf16*)(ws + WS_VSLC), (const bf16*)(ws + WS_KWIN), (const bf16*)(ws + WS_VWIN), GATES, SEL, OB, lds, tid, lane, wave);
                             nsa_sw_unit(bg >> 2, bg & 3, pi, QRAW, (const float*)args.in[I_NGQ] + (layer - 2) * DH, (const float*)(ws + WS_TABB), (const bf16*)(ws + WS_KSLC), (const bf16*)(ws + WS_VSLC), (const bf16*)(ws + WS_KWIN), (const bf16*)(ws + WS_VWIN), GATES, SEL, OB, lds, tid, lane, wave); }
                         __syncthreads(); cvt_range(args, 34 + 3 * (layer - 2), 1, lds, gw, NGW, wave, lane); PH_END
                }
                PH_BEGIN { NSA_PTRS const pg8::EpiResid E{nullptr, HB, nullptr, ssb + (size_t)(3 * layer + 2) * SSL, 1.0f, DM}; RUN_GEMM(pg8::EpiResid, E, OB, DM, wn + NSA_WIN_B, T, DM, DM, bx); cvt_range(args, 6 * layer + 3, 2, lds, gw, NGW, wave, lane); } PH_END
#if MK_PROBE == 9
                PH_BEGIN { NSA_PTRS const pg8::EpiResid E{(const float*)args.in[I_X], (pg8::bf16_t*)(ws + WS_QF), nullptr, nullptr, 1.0f, DM}; RUN_GEMM(pg8::EpiResid, E, OB, DM, wn + NSA_WIN_B, T, DM, DM, bx); } PH_END
#endif
            }
        }
        if (layer_i == 1) {
            REP(6) {
            PH_BEGIN { const float* ss6 = ssb + (size_t)6 * SSL;
                { RS_FILL(ss6, 64, 1.0f / DM, T, 2048, bx) const pg8::EpiScaleF32 E{KVS, NKV, ss6, 64, 1.0f / DM, rt_}; RUN_GEMM(pg8::EpiScaleF32, E, HB, DM, ws + WS_KVW, T, 2048, DM, bx); }
                for (int uid = bx; uid < 256; uid += G) { const int ks = uid >> 7, c2 = uid & 127; RS_FILL(ss6, 64, 1.0f / DM, T, 1024, c2)
                    const pg8::EpiScaleF32 E2{(float*)(ws + WS_ACT) + (size_t)ks * T * 1024, 1024, ss6, 64, 1.0f / DM, rt_};
                    const pg8::Gemm g2{(const pg8::bf16_t*)(HB + ks * 2048), (const pg8::bf16_t*)(ws + WS_KVW + (size_t)2048 * DM * 2) + (size_t)ks * 1024 * 2048, T, 1024, 2048, DM}; pg8::StaticOrder S2; S2.init(T, 1024, 128, c2);
                    pg8::gemm_phase<pg8::EpiScaleF32, pg8::StaticOrder, true, true>(lds, g2, S2, E2, opq_v(tid)); } } PH_END
            PH_BEGIN nsa_kv_finalize(args, gw, NGW, lane); PH_END
            PH_BEGIN {
                for (int uid = bx; uid < 128; uid += G) { const int mat = uid >> 6, ks = (uid >> 3) & 7, c2 = uid & 7;
                    const pg8::EpiPartF32 E{(float*)(ws + WS_KVS) + (size_t)(mat * 8 + ks) * CMP_ROWS_P * 256, 256};
                    const pg8::Gemm g2{(const pg8::bf16_t*)(ws + (mat ? WS_BLKV : WS_BLKK)) + ks * 512, (const pg8::bf16_t*)(ws + WS_CW1 + (size_t)mat * CW1_B + (size_t)ks * GSL_B), CMP_ROWS_P, 256, 512, 4096};
                    pg8::StaticOrder S2; S2.init(CMP_ROWS_P, 256, 8, c2); pg8::gemm_phase<pg8::EpiPartF32, pg8::StaticOrder, true, true>(lds, g2, S2, E, opq_v(tid)); } } PH_END
            PH_BEGIN nsa_cmp_out(args, lds, gw, NGW, wave, lane); __syncthreads(); cvt_range(args, 12, 2, lds, gw, NGW, wave, lane); PH_END
            }
        }
    }
#undef PH_BEGIN
#undef PH_END
#undef RUN_GEMM
}

extern "C" void kernel_launch(void* const* d_in, const int* in_sizes, int n_in, void* d_out, int out_size, void* d_ws, size_t ws_size, hipStream_t stream) {
    static int grid = 0;
    if (grid == 0) {
        if (n_in != 36 || in_sizes[0] != T * DM || out_size != T * DM || ws_size < WS_END) { fprintf(stderr, "kernel_launch: unexpected problem (n_in %d, in0 %d, out %d, ws %zu < %zu); nothing launched\n", n_in, n_in > 0 ? in_sizes[0] : -1, out_size, ws_size, (size_t)WS_END); grid = -1; return; }
        int dev = 0, cus = 0, per_cu = 0;
        if (hipGetDevice(&dev) != hipSuccess || hipDeviceGetAttribute(&cus, hipDeviceAttributeMultiprocessorCount, dev) != hipSuccess) { fprintf(stderr, "kernel_launch: device query failed\n"); grid = -1; return; }
        if (hipFuncSetAttribute((const void*)trunk_fwd, hipFuncAttributeMaxDynamicSharedMemorySize, LDS_BYTES) != hipSuccess) { fprintf(stderr, "kernel_launch: hipFuncSetAttribute failed\n"); grid = -1; return; }
        if (hipOccupancyMaxActiveBlocksPerMultiprocessor(&per_cu, (const void*)trunk_fwd, NTHREADS, LDS_BYTES) != hipSuccess || per_cu < 1) { fprintf(stderr, "kernel_launch: occupancy query reports %d workgroups per CU; nothing launched\n", per_cu); (void)hipGetLastError(); grid = -1; return; }
        grid = cus;
    }
    if (grid < 0) return;
    if (hipMemsetAsync((char*)d_ws + WS_CTL, 0, CTL_ZERO_BYTES, stream) != hipSuccess) { fprintf(stderr, "kernel_launch: hipMemsetAsync failed\n"); return; }
    Args a{};
    for (int i = 0; i < 36; ++i) a.in[i] = d_in[i];
    a.out = (float*)d_out; a.ws = (unsigned char*)d_ws;
#if MK_MULTI
    for (int p = 0; p < N_PHASES; ++p) { a.ph_lo = p; a.ph_hi = p + 1; hipLaunchKernelGGL(trunk_fwd, dim3(grid), dim3(NTHREADS), LDS_BYTES, stream, a); }
#else
    a.ph_lo = 0; a.ph_hi = MK_PROBE ? 1000 : N_PHASES; hipLaunchKernelGGL(trunk_fwd, dim3(grid), dim3(NTHREADS), LDS_BYTES, stream, a);
#endif
    const hipError_t le = hipPeekAtLastError();
    if (le != hipSuccess) fprintf(stderr, "kernel_launch: launch failed: %s\n", hipGetErrorName(le));
}
```

```cpp
#include <hip/hip_runtime.h>
#include <cstdio>
#include <cstdint>
namespace pg8 {
#define PG8_LAS __attribute__((address_space(3)))
typedef unsigned short bf16_t;
typedef short bf16x8 __attribute__((ext_vector_type(8)));
typedef float f32x4 __attribute__((ext_vector_type(4)));
typedef unsigned u32x4 __attribute__((ext_vector_type(4)));
constexpr int BM = 256, BK = 64, HALF = 128, HTB = HALF * BK * 2  , STAGE_BYTES = 8 * HTB, NXCD = 8, WGM = 8;

__host__ __device__ __forceinline__ int lds_byte(int r, int c) { const int st = (r >> 4) * 2 + (c >> 5), rr = r & 15, cc = c & 31, ob = rr * 64 + cc * 2; return st * 1024 + (ob ^ (((ob >> 9) & 1) << 5)); }
__host__ __device__ __forceinline__ void stage_rc(int b, int& R, int& C) { const int st = b / 1024, sb = b % 1024, swz = sb ^ (((sb >> 9) & 1) << 5); R = (st >> 1) * 16 + swz / 64; C = (st & 1) * 32 + (swz % 64) / 2; }
__host__ __device__ __forceinline__ int perm32(int rho) { const int n = rho >> 4, i = rho & 15; return 8 * (i >> 2) + 4 * n + (i & 3); }

struct Unit { int pm, pn; };
struct Gemm { const bf16_t* A; const bf16_t* Bt; int M, N, K, lda; };

struct StaticOrder {
    int nM, nN, nwg, G, c;
    __host__ __device__ __forceinline__ void init(int M, int N, int G_, int c_) { nM = M / BM; nN = N / BM; nwg = nM * nN; G = G_; c = c_; }
    __host__ __device__ __forceinline__ bool next(int i, Unit& u) const {
        const long L = (long)i * G + c; if (L >= nwg) return false;
        int wgid = (int)L; { const int q = nwg / NXCD, r = nwg % NXCD, xcd = wgid % NXCD, off = wgid / NXCD; wgid = (xcd < r ? xcd * (q + 1) : r * (q + 1) + (xcd - r) * q) + off; }
        const int nig = WGM * nN, gid = wgid / nig, fm = gid * WGM, gsz = (nM - fm) < WGM ? (nM - fm) : WGM;
        u.pm = fm + ((wgid % nig) % gsz); u.pn = (wgid % nig) / gsz; return true;
    }
    __device__ __forceinline__ void a_ready(const Unit&) const {}
    __device__ __forceinline__ void done(const Unit&) const {}
};

__device__ __forceinline__ unsigned cvt_pk_bf16(float lo, float hi) { unsigned r; asm volatile("s_nop 0\n\tv_cvt_pk_bf16_f32 %0, %1, %2\n\ts_nop 1" : "=v"(r) : "v"(lo), "v"(hi)); return r; }
constexpr float RMS_EPS = 1e-6f;
__device__ __forceinline__ float silu_f(float g) { return g * __builtin_amdgcn_rcpf(1.0f + __builtin_amdgcn_exp2f(-1.4426950408889634f * g)); }
__device__ __forceinline__ float sigmoid_f(float g) { return __builtin_amdgcn_rcpf(1.0f + __builtin_amdgcn_exp2f(-1.4426950408889634f * g)); }
__device__ __forceinline__ float shx(float v, int mask, int lane) { return __builtin_bit_cast(float, __builtin_amdgcn_ds_bpermute((lane ^ mask) << 2, __builtin_bit_cast(int, v))); }
__device__ __forceinline__ unsigned shxu(unsigned v, int mask, int lane) { return (unsigned)__builtin_amdgcn_ds_bpermute((lane ^ mask) << 2, (int)v); }
__device__ __forceinline__ float quad_sq(const f32x4 v) { return (v[0] * v[0] + v[1] * v[1]) + (v[2] * v[2] + v[3] * v[3]); }

__device__ __forceinline__ float row_rstd(const float* P, int row, int nparts, float inv_dim, int fq, int lane) {
    float s = 0.f; const float* p = P + (size_t)row * 64;
    if (nparts >= 16) { const int q = nparts >> 2; p += fq * q;
        for (int i = 0; i < q; i += 4) { const f32x4 v = *(const f32x4*)(p + i); s += (v[0] + v[1]) + (v[2] + v[3]); }
        s += shx(s, 16, lane); s += shx(s, 32, lane);
    } else { for (int i = 0; i < nparts; ++i) s += p[i]; }
    return __builtin_amdgcn_rsqf(s * inv_dim + RMS_EPS);
}
struct RsTab { const PG8_LAS float* tab; int pm; };
__device__ __forceinline__ float rs_lookup(const RsTab& t, const Unit& u, int lrow, const float* P, int row, int nparts, float inv_dim, int fq, int lane) {
    return (u.pm == t.pm) ? t.tab[lrow] : row_rstd(P, row, nparts, inv_dim, fq, lane);
}
__device__ __forceinline__ void rs_table_fill(PG8_LAS float* tab, const float* P, int nparts, float inv_dim, int pm, int tid, int lane) {
    const int r = tid >> 1, half = tid & 1; const float* p = P + ((size_t)pm * 256 + r) * 64; float s = 0.f;
    if (nparts >= 8) { const int per = nparts >> 1; p += half * per; for (int i = 0; i < per; i += 4) { const f32x4 v = *(const f32x4*)(p + i); s += (v[0] + v[1]) + (v[2] + v[3]); } }
    else if (half == 0) { for (int i = 0; i < nparts; ++i) s += p[i]; }
    s += shx(s, 1, lane);
    if (half == 0) tab[r] = __builtin_amdgcn_rsqf(s * inv_dim + RMS_EPS);
    __syncthreads();
}
struct EpiSwiGLU {
    static constexpr bool PERM = true, AFTER_DRAIN = false, ALIGN = true;
    bf16_t* O; int ldc; const float* ss; int nparts; float inv_dim; RsTab rt;
    __device__ __forceinline__ void operator()(const f32x4 (&acc)[2][2][4][2], const Unit& u, int wr, int wc, int fr, int fq) const {
        const int row0 = u.pm * BM + wr * 64 + fr, col0 = u.pn * HALF + wc * 32 + 8 * fq;
#ifndef MK_EPI2
#define MK_EPI2 1
#endif
#pragma nounroll
        for (int rep_ = 0; rep_ < MK_EPI2; ++rep_) { asm volatile("" ::: "memory");
#pragma unroll
        for (int ai = 0; ai < 2; ++ai)
#pragma unroll
            for (int m = 0; m < 4; ++m) { const int row = row0 + ai * HALF + m * 16; const float rs = rs_lookup(rt, u, row - u.pm * BM, ss, row, nparts, inv_dim, fq, fq * 16 + fr);
                typedef float f32x2e __attribute__((ext_vector_type(2)));
                float o[8]; const float nr = -1.4426950408889634f * rs, r2 = rs * rs; const f32x2e nr2 = {nr, nr}, rs2 = {r2, r2}, one2 = {1.0f, 1.0f};
#pragma unroll
                for (int n = 0; n < 2; ++n)
#pragma unroll
                    for (int jp = 0; jp < 2; ++jp) { const f32x2e g2 = {acc[ai][0][m][n][2 * jp], acc[ai][0][m][n][2 * jp + 1]}, u2 = {acc[ai][1][m][n][2 * jp], acc[ai][1][m][n][2 * jp + 1]};
                        const f32x2e t2 = g2 * nr2; const f32x2e d2 = (f32x2e){__builtin_amdgcn_exp2f(t2.x), __builtin_amdgcn_exp2f(t2.y)} + one2;
                        const f32x2e q2 = (g2 * u2) * rs2 * (f32x2e){__builtin_amdgcn_rcpf(d2.x), __builtin_amdgcn_rcpf(d2.y)};
                        o[4 * n + 2 * jp] = q2.x; o[4 * n + 2 * jp + 1] = q2.y; }
                u32x4 w; w.x = cvt_pk_bf16(o[0], o[1]); w.y = cvt_pk_bf16(o[2], o[3]); w.z = cvt_pk_bf16(o[4], o[5]); w.w = cvt_pk_bf16(o[6], o[7]);
                *(u32x4*)(O + (size_t)row * ldc + col0) = w; }
        }
    }
};
struct EpiResid {
    static constexpr bool PERM = true, AFTER_DRAIN = false, ALIGN = true;
    const float* xin; bf16_t* hb; float* fout; float* ssout; float scale; int ldc;
    __device__ __forceinline__ static f32x4 lo4(const u32x4 w) { return (f32x4){__builtin_bit_cast(float, w.x << 16), __builtin_bit_cast(float, w.x & 0xffff0000u), __builtin_bit_cast(float, w.y << 16), __builtin_bit_cast(float, w.y & 0xffff0000u)}; }
    __device__ __forceinline__ static f32x4 hi4(const u32x4 w) { return (f32x4){__builtin_bit_cast(float, w.z << 16), __builtin_bit_cast(float, w.z & 0xffff0000u), __builtin_bit_cast(float, w.w << 16), __builtin_bit_cast(float, w.w & 0xffff0000u)}; }
    __device__ __forceinline__ void finish(const f32x4 v0, const f32x4 v1, size_t o2, float& sq) const {
        sq += quad_sq(v0) + quad_sq(v1);
        if (fout) { __builtin_nontemporal_store(v0, (f32x4*)(fout + o2)); __builtin_nontemporal_store(v1, (f32x4*)(fout + o2 + 4)); }
        else { u32x4 w; w.x = cvt_pk_bf16(v0[0], v0[1]); w.y = cvt_pk_bf16(v0[2], v0[3]); w.z = cvt_pk_bf16(v1[0], v1[1]); w.w = cvt_pk_bf16(v1[2], v1[3]); *(u32x4*)(hb + o2) = w; } }
    __device__ __forceinline__ void operator()(const f32x4 (&acc)[2][2][4][2], const Unit& u, int wr, int wc, int fr, int fq) const {
        const int row0 = u.pm * BM + wr * 64 + fr, col0 = u.pn * BM + wc * 32 + 8 * fq;
#pragma unroll
        for (int ai = 0; ai < 2; ++ai) {
            if (xin) {
#pragma unroll
                for (int mp = 0; mp < 2; ++mp) { f32x4 hv[2][2][2];
#pragma unroll
                    for (int mm = 0; mm < 2; ++mm)
#pragma unroll
                        for (int bj = 0; bj < 2; ++bj) { const size_t o2 = (size_t)(row0 + ai * HALF + (2 * mp + mm) * 16) * ldc + col0 + bj * HALF; hv[mm][bj][0] = __builtin_nontemporal_load((const f32x4*)(xin + o2)); hv[mm][bj][1] = __builtin_nontemporal_load((const f32x4*)(xin + o2 + 4)); }
#pragma unroll
                    for (int mm = 0; mm < 2; ++mm) { const int m = 2 * mp + mm, row = row0 + ai * HALF + m * 16; float sq = 0.f;
#pragma unroll
                        for (int bj = 0; bj < 2; ++bj) finish(hv[mm][bj][0] + acc[ai][bj][m][0] * scale, hv[mm][bj][1] + acc[ai][bj][m][1] * scale, (size_t)row * ldc + col0 + bj * HALF, sq);
                        if (ssout) { sq += shx(sq, 16, fq * 16 + fr); sq += shx(sq, 32, fq * 16 + fr); if (fq == 0) ssout[(size_t)row * 64 + u.pn * 4 + wc] = sq; } }
                    asm volatile("" ::: "memory"); }
            } else {
                u32x4 raw[4][2];
#pragma unroll
                for (int m = 0; m < 4; ++m)
#pragma unroll
                    for (int bj = 0; bj < 2; ++bj) raw[m][bj] = *(const u32x4*)(hb + (size_t)(row0 + ai * HALF + m * 16) * ldc + col0 + bj * HALF);
#pragma unroll
                for (int m = 0; m < 4; ++m) { const int row = row0 + ai * HALF + m * 16; float sq = 0.f;
#pragma unroll
                    for (int bj = 0; bj < 2; ++bj) finish(lo4(raw[m][bj]) + acc[ai][bj][m][0] * scale, hi4(raw[m][bj]) + acc[ai][bj][m][1] * scale, (size_t)row * ldc + col0 + bj * HALF, sq);
                    if (ssout) { sq += shx(sq, 16, fq * 16 + fr); sq += shx(sq, 32, fq * 16 + fr); if (fq == 0) ssout[(size_t)row * 64 + u.pn * 4 + wc] = sq; } }
                asm volatile("" ::: "memory"); }
        }
    }
};
struct EpiScaleBf16 {
    static constexpr bool PERM = true, AFTER_DRAIN = false, ALIGN = true;
    bf16_t* O; int ldc; const float* ss; int nparts; float inv_dim; float* ssA; float* ssB; int t0, t1; RsTab rt;
    __device__ __forceinline__ void operator()(const f32x4 (&acc)[2][2][4][2], const Unit& u, int wr, int wc, int fr, int fq) const {
        const int row0 = u.pm * BM + wr * 64 + fr, col0 = u.pn * BM + wc * 32 + 8 * fq;
        float* sso = (u.pn < t0) ? ssA : ((u.pn < t1) ? ssB : nullptr);
#pragma unroll
        for (int ai = 0; ai < 2; ++ai)
#pragma unroll
            for (int m = 0; m < 4; ++m) { const int row = row0 + ai * HALF + m * 16; const float rs = rs_lookup(rt, u, row - u.pm * BM, ss, row, nparts, inv_dim, fq, fq * 16 + fr); float sq = 0.f;
#pragma unroll
                for (int bj = 0; bj < 2; ++bj) { const f32x4 v0 = acc[ai][bj][m][0] * rs, v1 = acc[ai][bj][m][1] * rs; sq += quad_sq(v0) + quad_sq(v1);
                    u32x4 w; w.x = cvt_pk_bf16(v0[0], v0[1]); w.y = cvt_pk_bf16(v0[2], v0[3]); w.z = cvt_pk_bf16(v1[0], v1[1]); w.w = cvt_pk_bf16(v1[2], v1[3]);
                    *(u32x4*)(O + (size_t)row * ldc + col0 + bj * HALF) = w; }
                if (sso) { sq += shx(sq, 16, fq * 16 + fr); sq += shx(sq, 32, fq * 16 + fr); if (fq == 0) sso[(size_t)row * 64 + (u.pn < t0 ? u.pn : u.pn - t0) * 4 + wc] = sq; } }
    }
};
struct EpiScaleF32 {
    static constexpr bool PERM = false, AFTER_DRAIN = false, ALIGN = true;
    float* C; int ldc; const float* ss; int nparts; float inv_dim; RsTab rt;
    __device__ __forceinline__ void operator()(const f32x4 (&acc)[2][2][4][2], const Unit& u, int wr, int wc, int fr, int fq) const {
        const int row0 = u.pm * BM + wr * 64 + fr, col0 = u.pn * BM + wc * 32 + 4 * fq;
#pragma unroll
        for (int ai = 0; ai < 2; ++ai)
#pragma unroll
            for (int m = 0; m < 4; ++m) { const int row = row0 + ai * HALF + m * 16; const float rs = rs_lookup(rt, u, row - u.pm * BM, ss, row, nparts, inv_dim, fq, fq * 16 + fr); float* rowp = C + (size_t)row * ldc + col0;
#pragma unroll
                for (int bj = 0; bj < 2; ++bj)
#pragma unroll
                    for (int n = 0; n < 2; ++n) *(f32x4*)(rowp + bj * HALF + n * 16) = acc[ai][bj][m][n] * rs; }
    }
};
struct EpiNsaIn {
    static constexpr bool PERM = true, AFTER_DRAIN = false, ALIGN = true;
    bf16_t* Q; float* gates; const float* bgate; const float* ss; int nparts; float inv_dim; RsTab rt;
    __device__ __forceinline__ void operator()(const f32x4 (&acc)[2][2][4][2], const Unit& u, int wr, int wc, int fr, int fq) const {
        const int row0 = u.pm * BM + wr * 64 + fr, lc0 = wc * 32 + 8 * fq;
#pragma unroll
        for (int ai = 0; ai < 2; ++ai)
#pragma unroll
            for (int m = 0; m < 4; ++m) { const int row = row0 + ai * HALF + m * 16; const float rs = rs_lookup(rt, u, row - u.pm * BM, ss, row, nparts, inv_dim, fq, fq * 16 + fr);
                if (u.pn < 16) {
#pragma unroll
                    for (int bj = 0; bj < 2; ++bj) { const f32x4 v0 = acc[ai][bj][m][0] * rs, v1 = acc[ai][bj][m][1] * rs;
                        u32x4 w; w.x = cvt_pk_bf16(v0[0], v0[1]); w.y = cvt_pk_bf16(v0[2], v0[3]); w.z = cvt_pk_bf16(v1[0], v1[1]); w.w = cvt_pk_bf16(v1[2], v1[3]);
                        *(u32x4*)(Q + (size_t)row * 4096 + u.pn * BM + lc0 + bj * HALF) = w; }
                } else if (lc0 < 96) {
#pragma unroll
                    for (int n = 0; n < 2; ++n) { const f32x4 b = *(const f32x4*)(bgate + lc0 + 4 * n); f32x4 v = acc[ai][0][m][n] * rs + b;
                        v[0] = sigmoid_f(v[0]); v[1] = sigmoid_f(v[1]); v[2] = sigmoid_f(v[2]); v[3] = sigmoid_f(v[3]);
                        *(f32x4*)(gates + (size_t)row * 96 + lc0 + 4 * n) = v; }
                } }
    }
};
struct EpiGateP {
    static constexpr bool PERM = true, AFTER_DRAIN = false, ALIGN = true;
    float* P; const float* ss; int nparts; float inv_dim; RsTab rt;
    __device__ __forceinline__ void operator()(const f32x4 (&acc)[2][2][4][2], const Unit& u, int wr, int wc, int fr, int fq) const {
        const int row0 = u.pm * BM + wr * 64 + fr, lc0 = wc * 32 + 8 * fq;
#pragma unroll
        for (int ai = 0; ai < 2; ++ai)
#pragma unroll
            for (int m = 0; m < 4; ++m) { const int row = row0 + ai * HALF + m * 16; const float rs = rs_lookup(rt, u, row - u.pm * BM, ss, row, nparts, inv_dim, fq, fq * 16 + fr);
                if (lc0 < 96) {
#pragma unroll
                    for (int n = 0; n < 2; ++n) *(f32x4*)(P + (size_t)row * 96 + lc0 + 4 * n) = acc[ai][0][m][n] * rs; } }
    }
};
struct EpiPartF32 {
    static constexpr bool PERM = false, AFTER_DRAIN = false, ALIGN = true;
    float* C; int ldc;
    __device__ __forceinline__ void operator()(const f32x4 (&acc)[2][2][4][2], const Unit& u, int wr, int wc, int fr, int fq) const {
        const int row0 = u.pm * BM + wr * 64 + fr, col0 = u.pn * BM + wc * 32 + 4 * fq;
#pragma unroll
        for (int ai = 0; ai < 2; ++ai)
#pragma unroll
            for (int m = 0; m < 4; ++m) { float* rowp = C + (size_t)(row0 + ai * HALF + m * 16) * ldc + col0;
#pragma unroll
                for (int bj = 0; bj < 2; ++bj)
#pragma unroll
                    for (int n = 0; n < 2; ++n) *(f32x4*)(rowp + bj * HALF + n * 16) = acc[ai][bj][m][n]; }
    }
};
struct EpiCmpHidden {
    static constexpr bool PERM = true, AFTER_DRAIN = false, ALIGN = true;
    bf16_t* O; const float* b1;
    __device__ __forceinline__ void operator()(const f32x4 (&acc)[2][2][4][2], const Unit& u, int wr, int wc, int fr, int fq) const {
        const int row0 = u.pm * BM + wr * 64 + fr, col0 = wc * 32 + 8 * fq;
#pragma unroll
        for (int ai = 0; ai < 2; ++ai)
#pragma unroll
            for (int m = 0; m < 4; ++m) { const int row = row0 + ai * HALF + m * 16;
#pragma unroll
                for (int bj = 0; bj < 2; ++bj) { const f32x4 b0 = *(const f32x4*)(b1 + col0 + bj * HALF), bb1 = *(const f32x4*)(b1 + col0 + bj * HALF + 4);
                    const f32x4 v0 = acc[ai][bj][m][0] + b0, v1 = acc[ai][bj][m][1] + bb1;
                    u32x4 w; w.x = cvt_pk_bf16(silu_f(v0[0]), silu_f(v0[1])); w.y = cvt_pk_bf16(silu_f(v0[2]), silu_f(v0[3])); w.z = cvt_pk_bf16(silu_f(v1[0]), silu_f(v1[1])); w.w = cvt_pk_bf16(silu_f(v1[2]), silu_f(v1[3]));
                    *(u32x4*)(O + (size_t)row * 256 + col0 + bj * HALF) = w; } }
    }
};

template <class Epi, class Sched, bool ALIGN_EPI = false, bool SP2 = false>
__device__ __forceinline__ void gemm_phase(PG8_LAS unsigned char* lds, const Gemm g, const Sched& S, const Epi& E, const int tid) {
    const int wid = __builtin_amdgcn_readfirstlane(tid >> 6), lane = tid & 63, wr = wid >> 2, wc = wid & 3, fr = lane & 15, fq = lane >> 4;
    const int K = g.K, nt = K / BK;
    unsigned voffA[2], voffB[2];
#pragma unroll
    for (int i = 0; i < 2; ++i) { int R, C; stage_rc(tid * 16 + i * 8192, R, C); const int Rb = Epi::PERM ? ((R & ~31) + perm32(R & 31)) : R;
        voffA[i] = (unsigned)(R * g.lda + C) * 2u; voffB[i] = (unsigned)(Rb * K + C) * 2u; }
    const size_t kstep = (size_t)(BK * 2);
    const size_t hstepA = (size_t)HALF * g.lda * 2, hstepB = (size_t)HALF * K * 2;
    const size_t tstepA = 2 * hstepA, tstepB = 2 * hstepB;
    const unsigned ldsw = (unsigned)wid * 1024u;
    const int aoff = lds_byte(wr * 64 + fr, fq * 8), boff = lds_byte(wc * 32 + fr, fq * 8);
#define PG8_SA(b, h) (((b) * 2 + (h)) * HTB)
#define PG8_SB(b, h) ((4 + (b) * 2 + (h)) * HTB)
#define PG8_STAGE(bufoff, gbase, voff) do { _Pragma("unroll") for (int _i = 0; _i < 2; ++_i) \
        __builtin_amdgcn_global_load_lds((const unsigned*)((const char*)(gbase) + (voff)[_i]), (PG8_LAS unsigned*)(lds + (bufoff) + ldsw + _i * 8192), 16, 0, 0); } while (0)
#define PG8_LDA(dst, b, h) do { _Pragma("unroll") for (int m = 0; m < 4; ++m) _Pragma("unroll") for (int k = 0; k < 2; ++k) dst[m][k] = *(const PG8_LAS bf16x8*)(lds + PG8_SA(b, h) + aoff + m * 2048 + k * 1024); } while (0)
#define PG8_LDB(dst, b, h) do { _Pragma("unroll") for (int n = 0; n < 2; ++n) _Pragma("unroll") for (int k = 0; k < 2; ++k) dst[n][k] = *(const PG8_LAS bf16x8*)(lds + PG8_SB(b, h) + boff + n * 2048 + k * 1024); } while (0)
#define PG8_MMA(ai, bj, At, Bt) do { __builtin_amdgcn_s_setprio(1); _Pragma("unroll") for (int m = 0; m < 4; ++m) _Pragma("unroll") for (int n = 0; n < 2; ++n) _Pragma("unroll") for (int k = 0; k < 2; ++k) \
        acc[ai][bj][m][n] = __builtin_amdgcn_mfma_f32_16x16x32_bf16(Bt[n][k], At[m][k], acc[ai][bj][m][n], 0, 0, 0); __builtin_amdgcn_s_setprio(0); } while (0)
#define PG8_WAIT_V(n) asm volatile("s_waitcnt vmcnt(" #n ")" ::: "memory")
#define PG8_WAIT_L(n) asm volatile("s_waitcnt lgkmcnt(" #n ")" ::: "memory")
#define PG8_BAR __builtin_amdgcn_s_barrier()
#define PG8_SCHED __builtin_amdgcn_sched_barrier(0)
    Unit cur, nxt; int ui = 0;
    if (!S.next(0, cur)) return;
    f32x4 acc[2][2][4][2];
#pragma unroll
    for (int a = 0; a < 2; ++a)
#pragma unroll
        for (int b = 0; b < 2; ++b)
#pragma unroll
            for (int m = 0; m < 4; ++m)
#pragma unroll
                for (int n = 0; n < 2; ++n) acc[a][b][m][n] = (f32x4){0.f, 0.f, 0.f, 0.f};
    bf16x8 At[4][2], B0[2][2], B1[2][2];
    const char* cA = (const char*)g.A + (size_t)cur.pm * tstepA; const char* cB = (const char*)g.Bt + (size_t)cur.pn * tstepB;
    S.a_ready(cur);
    if constexpr (SP2) {
        PG8_STAGE(PG8_SB(0, 0), cB, voffB); PG8_STAGE(PG8_SB(0, 1), cB + hstepB, voffB); PG8_STAGE(PG8_SA(0, 0), cA, voffA); PG8_STAGE(PG8_SA(0, 1), cA + hstepA, voffA);
        if (wr == 1) PG8_BAR;
        PG8_WAIT_V(2); PG8_BAR;
        PG8_STAGE(PG8_SB(1, 0), cB + kstep, voffB); PG8_STAGE(PG8_SA(1, 0), cA + kstep, voffA); PG8_STAGE(PG8_SB(1, 1), cB + hstepB + kstep, voffB);
        PG8_WAIT_V(6); PG8_BAR;
    } else {
        PG8_STAGE(PG8_SB(0, 0), cB, voffB); PG8_STAGE(PG8_SA(0, 0), cA, voffA); PG8_STAGE(PG8_SB(0, 1), cB + hstepB, voffB); PG8_STAGE(PG8_SA(0, 1), cA + hstepA, voffA);
        if (wr == 1) PG8_BAR;
        PG8_WAIT_V(4); PG8_BAR;
        PG8_STAGE(PG8_SB(1, 0), cB + kstep, voffB); PG8_STAGE(PG8_SA(1, 0), cA + kstep, voffA); PG8_STAGE(PG8_SB(1, 1), cB + hstepB + kstep, voffB);
        PG8_WAIT_V(6); PG8_BAR;
    }
    for (;;) {
        const bool has_next = S.next(ui + 1, nxt);
        const char* nA = has_next ? (const char*)g.A + (size_t)nxt.pm * tstepA : cA; const char* nB = has_next ? (const char*)g.Bt + (size_t)nxt.pn * tstepB : cB;
        for (int t = 0; t < nt; t += 2) {
            const bool last = (t == nt - 2);
            const char* a1 = cA + (size_t)(t + 1) * kstep;
            const char* a2 = last ? nA : cA + (size_t)(t + 2) * kstep; const char* b2 = last ? nB : cB + (size_t)(t + 2) * kstep;
            const char* a3 = a2 + kstep; const char* b3 = b2 + kstep;
            if (last && has_next) S.a_ready(nxt);
            if constexpr (SP2) {
            PG8_LDB(B0, 0, 0); PG8_LDB(B1, 0, 1); PG8_SCHED; PG8_LDA(At, 0, 0); PG8_STAGE(PG8_SA(1, 1), a1 + hstepA, voffA);
            PG8_WAIT_V(8); PG8_WAIT_L(0); PG8_BAR; PG8_MMA(0, 0, At, B0); PG8_MMA(0, 1, At, B1); PG8_BAR; PG8_SCHED;
            PG8_LDA(At, 0, 1); PG8_STAGE(PG8_SB(0, 0), b2, voffB); PG8_STAGE(PG8_SB(0, 1), b2 + hstepB, voffB); PG8_STAGE(PG8_SA(0, 0), a2, voffA);
            PG8_WAIT_V(8); PG8_WAIT_L(0); PG8_BAR; PG8_MMA(1, 0, At, B0); PG8_MMA(1, 1, At, B1); PG8_BAR; PG8_SCHED;
            PG8_LDB(B0, 1, 0); PG8_LDB(B1, 1, 1); PG8_SCHED; PG8_LDA(At, 1, 0); PG8_STAGE(PG8_SA(0, 1), a2 + hstepA, voffA);
            PG8_WAIT_V(8); PG8_WAIT_L(0); PG8_BAR; PG8_MMA(0, 0, At, B0); PG8_MMA(0, 1, At, B1); PG8_BAR; PG8_SCHED;
            PG8_LDA(At, 1, 1); PG8_STAGE(PG8_SB(1, 0), b3, voffB); PG8_STAGE(PG8_SB(1, 1), b3 + hstepB, voffB); PG8_STAGE(PG8_SA(1, 0), a3, voffA);
            PG8_WAIT_V(8); PG8_WAIT_L(0); PG8_BAR; PG8_MMA(1, 0, At, B0); PG8_MMA(1, 1, At, B1); PG8_BAR; PG8_SCHED;
            } else {
            PG8_LDB(B0, 0, 0); PG8_SCHED; PG8_LDA(At, 0, 0); PG8_STAGE(PG8_SA(1, 1), a1 + hstepA, voffA);
            PG8_WAIT_L(8); PG8_BAR; PG8_WAIT_L(0); PG8_MMA(0, 0, At, B0); PG8_BAR; PG8_SCHED;
            PG8_LDB(B1, 0, 1); PG8_STAGE(PG8_SB(0, 0), b2, voffB);
            PG8_BAR; PG8_WAIT_L(0); PG8_MMA(0, 1, At, B1); PG8_BAR;
            PG8_LDA(At, 0, 1); PG8_STAGE(PG8_SA(0, 0), a2, voffA);
            PG8_BAR; PG8_WAIT_L(0); PG8_MMA(1, 0, At, B0); PG8_BAR; PG8_SCHED;
            PG8_STAGE(PG8_SB(0, 1), b2 + hstepB, voffB);
            PG8_WAIT_V(6); PG8_BAR; PG8_MMA(1, 1, At, B1); PG8_BAR;
            PG8_LDB(B0, 1, 0); PG8_SCHED; PG8_LDA(At, 1, 0); PG8_STAGE(PG8_SA(0, 1), a2 + hstepA, voffA);
            PG8_WAIT_L(8); PG8_BAR; PG8_WAIT_L(0); PG8_MMA(0, 0, At, B0); PG8_BAR; PG8_SCHED;
            PG8_LDB(B1, 1, 1); PG8_STAGE(PG8_SB(1, 0), b3, voffB);
            PG8_BAR; PG8_WAIT_L(0); PG8_MMA(0, 1, At, B1); PG8_BAR;
            PG8_LDA(At, 1, 1); PG8_STAGE(PG8_SA(1, 0), a3, voffA);
            PG8_BAR; PG8_WAIT_L(0); PG8_MMA(1, 0, At, B0); PG8_BAR; PG8_SCHED;
            PG8_STAGE(PG8_SB(1, 1), b3 + hstepB, voffB);
            PG8_WAIT_V(6); PG8_BAR; PG8_MMA(1, 1, At, B1); PG8_BAR;
            }
        }
        if constexpr (ALIGN_EPI) { if (wr == 0) PG8_BAR; }
        if constexpr (!Epi::AFTER_DRAIN) { E(acc, cur, wr, wc, fr, fq); S.done(cur); }
        if (!has_next) break;
#pragma unroll
        for (int a = 0; a < 2; ++a)
#pragma unroll
            for (int b = 0; b < 2; ++b)
#pragma unroll
                for (int m = 0; m < 4; ++m)
#pragma unroll
                    for (int n = 0; n < 2; ++n) acc[a][b][m][n] = (f32x4){0.f, 0.f, 0.f, 0.f};
        cur = nxt; cA = nA; cB = nB; ++ui;
        if constexpr (ALIGN_EPI) { if (wr == 1) PG8_BAR; }
    }
    PG8_WAIT_V(0);
    if constexpr (!ALIGN_EPI) { if (wr == 0) PG8_BAR; }
    PG8_BAR;
    if constexpr (Epi::AFTER_DRAIN) { E.fused(acc, cur, wr, wc, fr, fq, lds, wid, lane); S.done(cur); }
#undef PG8_SA
#undef PG8_SB
#undef PG8_STAGE
#undef PG8_LDA
#undef PG8_LDB
#undef PG8_MMA
#undef PG8_WAIT_V
#undef PG8_WAIT_L
#undef PG8_BAR
#undef PG8_SCHED
}
}

using pg8::bf16x8; using pg8::f32x4; using pg8::u32x4; using pg8::cvt_pk_bf16;
typedef unsigned short bf16;
typedef float f32x16 __attribute__((ext_vector_type(16)));
typedef short s16x4 __attribute__((ext_vector_type(4)));
typedef unsigned u32x2 __attribute__((ext_vector_type(2)));

constexpr int DM = 4096, BATCH = 4, SEQ = 2048, T = BATCH * SEQ, FF = 6144, DEPTH = 4;
constexpr int MLA_H = 32, QLORA = 1024, KVLORA = 512, MLA_QK = 192, MLA_IN = 1600, MLA_IN_P = 1792;
constexpr int NSA_G = 4, HPG = 8, DH = 128, NKV = 3072, NSA_IN = 4192, NSA_IN_P = 4352;
constexpr int NCMP = 127, CMP_ROWS = BATCH * NCMP * NSA_G  , CMP_ROWS_P = 2048, CMP_HID = 256;
constexpr float EPS = 1e-6f, NEGF = -1e30f, LOG2E = 1.4426950408889634f;
constexpr int NWAVES = 8, NTHREADS = 512;

constexpr size_t MiB = 1u << 20;
constexpr size_t WS_CTL = 0, CTL_ZERO_BYTES = 64 * 1024;
constexpr int CW_BAR = 4096;
constexpr size_t SS_SLOT_B = (size_t)8192 * 64 * 4;
constexpr int SS_CQ = 12, SS_CKV = 14;
constexpr size_t FFN_GU_B = (size_t)2 * FF * DM * 2, FFN_D_B = (size_t)DM * FF * 2, FFN_B = FFN_GU_B + FFN_D_B;
constexpr size_t SS_OFF = 1 * MiB;
constexpr size_t WS_FFN = SS_OFF + 16 * SS_SLOT_B;
constexpr size_t WS_MLA = WS_FFN + 8 * FFN_B;
constexpr size_t MLA_WIN_B = (size_t)MLA_IN_P * DM * 2, MLA_WUQ_B = (size_t)6144 * QLORA * 2, MLA_WUKV_B = (size_t)8192 * KVLORA * 2, WO_B = (size_t)DM * DM * 2;
constexpr size_t MLA_B = MLA_WIN_B + MLA_WUQ_B + MLA_WUKV_B + WO_B;
constexpr size_t WS_NSA = WS_MLA + 2 * MLA_B;
constexpr size_t NSA_WIN_B = (size_t)NSA_IN_P * DM * 2, NSA_B = NSA_WIN_B + WO_B;
constexpr size_t WS_KVW = WS_NSA + 2 * NSA_B, KVW_B = (size_t)NKV * DM * 2;
constexpr size_t WS_CW1 = WS_KVW + KVW_B, CW1_B = (size_t)CMP_HID * 4096 * 2;
constexpr size_t WS_HB = WS_CW1 + 2 * CW1_B;
constexpr size_t WS_ACT = WS_HB + (size_t)T * DM * 2;
constexpr size_t WS_CBUF = WS_ACT + (size_t)T * FF * 2;
constexpr size_t WS_QRAW = WS_CBUF + (size_t)T * MLA_IN_P * 2;
constexpr size_t WS_KVRAW = WS_QRAW + (size_t)T * 6144 * 2;
constexpr size_t WS_QF = WS_KVRAW + (size_t)T * 8192 * 2;
constexpr size_t WS_KF = WS_QF + (size_t)T * 32 * 192 * 2;
constexpr size_t WS_OB = WS_KF + (size_t)T * 32 * 192 * 2;
constexpr size_t WS_GATES = WS_OB + (size_t)T * DM * 2;
constexpr size_t WS_SEL = WS_GATES + (size_t)T * 96 * 4;
constexpr size_t WS_KVS = WS_SEL + (size_t)BATCH * NSA_G * SEQ * 4;
constexpr size_t WS_KSLC = WS_KVS + (size_t)T * NKV * 4;
constexpr size_t WS_KWIN = WS_KSLC + (size_t)T * 512 * 2, WS_VSLC = WS_KWIN + (size_t)T * 512 * 2, WS_VWIN = WS_VSLC + (size_t)T * 512 * 2;
constexpr size_t WS_BLKK = WS_VWIN + (size_t)T * 512 * 2, WS_BLKV = WS_BLKK + (size_t)CMP_ROWS_P * 4096 * 2;
constexpr size_t WS_HIDK = WS_BLKV + (size_t)CMP_ROWS_P * 4096 * 2, WS_HIDV = WS_HIDK + (size_t)CMP_ROWS_P * 256 * 2;
constexpr size_t WS_KC = WS_HIDV + (size_t)CMP_ROWS_P * 256 * 2, WS_VC = WS_KC + (size_t)16 * 128 * 128 * 2;
constexpr size_t WS_TABA = WS_VC + (size_t)16 * 128 * 128 * 2;
constexpr size_t WS_TABB = WS_TABA + (size_t)T * 32 * 4 * 2;
constexpr size_t WS_GP = WS_TABB + (size_t)T * 64 * 4 * 2;
constexpr size_t WS_END = WS_GP + (size_t)8 * T * 96 * 4;
constexpr size_t NSA_WQ_B = (size_t)4096 * DM * 2, GSL_B = (size_t)256 * 512 * 2;
static_assert((CW_BAR + 3456) * 4 <= (int)CTL_ZERO_BYTES && CTL_ZERO_BYTES <= SS_OFF, "zeroed region");
static_assert(WS_HB % 256 == 0 && WS_END < ((size_t)3000 << 20), "d_ws map");

constexpr int RING_BYTES = 131072;
constexpr int LDSCTL_OFF = RING_BYTES, MISC_OFF = LDSCTL_OFF + 320, RSTAB_OFF = LDSCTL_OFF + 1024;
constexpr int LDS_BYTES = 147456;

#define GAS __attribute__((address_space(1)))
#define LAS __attribute__((address_space(3)))
#define RLX_AGENT __ATOMIC_RELAXED, __HIP_MEMORY_SCOPE_AGENT
#define LDS_WAIT() asm volatile("s_waitcnt lgkmcnt(0)" ::: "memory")
__device__ __forceinline__ unsigned f2bf(float f) { unsigned u = __builtin_bit_cast(unsigned, f); return (u + 0x7fffu + ((u >> 16) & 1u)) >> 16; }
__device__ __forceinline__ unsigned pk2(float lo, float hi) { return f2bf(lo) | (f2bf(hi) << 16); }
__device__ __forceinline__ float bf2f(bf16 b) { return __builtin_bit_cast(float, (unsigned)b << 16); }
using pg8::shx; using pg8::shxu;
__device__ __forceinline__ float wave_sum(float v, int lane) {
#pragma unroll
    for (int o = 1; o < 64; o <<= 1) v += shx(v, o, lane);
    return v;
}

#define XB_TMO      128
#define XB_XCNT(j)  (256  + 64 * (j))
#define XB_XSUB(j)  (1280 + 64 * (j))
#define XB_XGEN(j)  (2304 + 64 * (j))
#define XB_TOP      3328
#define XB_TOPGEN   3392
#define XCD_BAR_WORDS 3456
#define XB_SPIN_CAP (1u << 18)

__device__ __forceinline__ unsigned xb_ld(unsigned* p)              { return __hip_atomic_load(p, __ATOMIC_RELAXED, __HIP_MEMORY_SCOPE_AGENT); }
__device__ __forceinline__ unsigned xb_add(unsigned* p, unsigned v) { return __hip_atomic_fetch_add(p, v, __ATOMIC_RELAXED, __HIP_MEMORY_SCOPE_AGENT); }
__device__ __forceinline__ unsigned xb_xcc_id() { return (unsigned)__builtin_amdgcn_s_getreg((3 << 11) | 20) & 0xFu; }
#define XB_SPIN(cond, bar) do { unsigned _sp = 0; while (cond) { __builtin_amdgcn_s_sleep(1); \
    if ((++_sp & 255u) == 0u) { if (xb_ld(&(bar)[XB_TMO])) break; if (_sp > XB_SPIN_CAP) { atomicAdd(&(bar)[XB_TMO], 1u); break; } } } } while (0)

struct XcdBarrier {
    unsigned* bar; unsigned x;
    volatile LAS unsigned* st;
};

__device__ __forceinline__ XcdBarrier xcd_barrier_post(unsigned* bar, volatile LAS unsigned* st) {
    XcdBarrier b; b.bar = bar; b.x = xb_xcc_id(); b.st = st;
    if (threadIdx.x == 0) (void)xb_add(&bar[XB_XCNT(b.x)], 1u);
    return b;
}
__device__ __forceinline__ void xcd_barrier_complete(unsigned* bar, unsigned x, unsigned& nloc, unsigned& nx) {
    const unsigned G = gridDim.x * gridDim.y * gridDim.z;
    unsigned sum, cnt, mine, sp = 0u;
    for (;;) {
        sum = 0u; cnt = 0u; mine = 0u;
#pragma unroll
        for (unsigned j = 0; j < 16; ++j) { const unsigned c = xb_ld(&bar[XB_XCNT(j)]); sum += c; cnt += (c > 0u) ? 1u : 0u; mine = (j == x) ? c : mine; }
        if (sum == G) break;
        __builtin_amdgcn_s_sleep(1);
        if ((++sp & 255u) == 0u) { if (xb_ld(&bar[XB_TMO])) break; if (sp > XB_SPIN_CAP) { atomicAdd(&bar[XB_TMO], 1u); break; } }
    }
    nloc = mine > 0u ? mine : 1u; nx = cnt > 0u ? cnt : 1u;
}

__device__ __forceinline__ void xcd_barrier(const XcdBarrier& b) {
    asm volatile("s_waitcnt vmcnt(0)" ::: "memory");
    __syncthreads();
    if (threadIdx.x == 0) {
        unsigned* bar = b.bar;
        __builtin_amdgcn_s_waitcnt(0);
        unsigned nloc = b.st[0], nx = b.st[1];
        if (nloc == 0u) { xcd_barrier_complete(bar, b.x, nloc, nx); b.st[0] = nloc; b.st[1] = nx; }
        const unsigned old = xb_add(&bar[XB_XSUB(b.x)], 1u);
        const unsigned gen = old / nloc;
        if (old + 1u == (gen + 1u) * nloc) {
            __builtin_amdgcn_fence(__ATOMIC_RELEASE, "agent");
            asm volatile("s_waitcnt vmcnt(0)" ::: "memory");
            const unsigned og = xb_add(&bar[XB_TOP], 1u);
            const unsigned tg = og / nx;
            if (og + 1u == (tg + 1u) * nx) xb_add(&bar[XB_TOPGEN], 1u);
            else XB_SPIN(xb_ld(&bar[XB_TOPGEN]) == tg, bar);
            __builtin_amdgcn_fence(__ATOMIC_ACQUIRE, "agent");
            xb_add(&bar[XB_XGEN(b.x)], 1u);
            asm volatile("s_waitcnt vmcnt(0)" ::: "memory");
        } else {
            XB_SPIN(xb_ld(&bar[XB_XGEN(b.x)]) == gen, bar);
            __builtin_amdgcn_fence(__ATOMIC_ACQUIRE, "agent");
            asm volatile("s_waitcnt vmcnt(0)" ::: "memory");
        }
    }
    __syncthreads();
}

typedef GAS unsigned gu32;

struct Args { const void* in[36]; float* out; unsigned char* ws; int ph_lo, ph_hi; };
enum { I_X = 0, I_POS, I_F1N, I_F1G, I_F1U, I_F1D, I_MIXN, I_F2N, I_F2G, I_F2U, I_F2D, I_MWIN, I_MGCQ, I_MGCKV, I_MWUQ, I_MWUKV, I_MGQ, I_MGK, I_MWO,
       I_KVN, I_KVW, I_CPK, I_CPV, I_CKW1, I_CKB1, I_CKW2, I_CVW1, I_CVB1, I_CVW2, I_GKC, I_GKS, I_GKW, I_NWIN, I_NBG, I_NGQ, I_NWO };

struct CvtJob { const float* W; const float* gain; bf16* WT; int K, N, mode, ldw; };
constexpr int N_CVT_JOBS = 42;
template <class ArgsT> __device__ __forceinline__ CvtJob get_job(const ArgsT& a, int j) {
    CvtJob jb; unsigned char* ws = a.ws; jb.ldw = 0;
    if (j < 24) { const int l = j / 6, r = j % 6, which = r / 3, mat = r % 3;
        const float* norm = (const float*)a.in[which ? I_F2N : I_F1N] + (size_t)l * DM;
        bf16* gu = (bf16*)(ws + WS_FFN + (size_t)(l * 2 + which) * FFN_B);
        if (mat == 0)      { jb.W = (const float*)a.in[which ? I_F2G : I_F1G] + (size_t)l * DM * FF; jb.gain = norm; jb.WT = gu; jb.K = DM; jb.N = FF; jb.mode = 1; }
        else if (mat == 1) { jb.W = (const float*)a.in[which ? I_F2U : I_F1U] + (size_t)l * DM * FF; jb.gain = norm; jb.WT = gu; jb.K = DM; jb.N = FF; jb.mode = 2; }
        else               { jb.W = (const float*)a.in[which ? I_F2D : I_F1D] + (size_t)l * FF * DM; jb.gain = nullptr; jb.WT = (bf16*)((unsigned char*)gu + FFN_GU_B); jb.K = FF; jb.N = DM; jb.mode = 0; }
    } else if (j < 32) { const int l = (j - 24) / 4, r = (j - 24) % 4; unsigned char* base = ws + WS_MLA + (size_t)l * MLA_B; jb.mode = 0;
        if (r == 0)      { jb.W = (const float*)a.in[I_MWIN] + (size_t)l * DM * MLA_IN; jb.gain = (const float*)a.in[I_MIXN] + (size_t)l * DM; jb.WT = (bf16*)base; jb.K = DM; jb.N = MLA_IN; }
        else if (r == 1) { jb.W = (const float*)a.in[I_MWUQ] + (size_t)l * QLORA * 6144; jb.gain = (const float*)a.in[I_MGCQ] + (size_t)l * QLORA; jb.WT = (bf16*)(base + MLA_WIN_B); jb.K = QLORA; jb.N = 6144; }
        else if (r == 2) { jb.W = (const float*)a.in[I_MWUKV] + (size_t)l * KVLORA * 8192; jb.gain = (const float*)a.in[I_MGCKV] + (size_t)l * KVLORA; jb.WT = (bf16*)(base + MLA_WIN_B + MLA_WUQ_B); jb.K = KVLORA; jb.N = 8192; }
        else             { jb.W = (const float*)a.in[I_MWO] + (size_t)l * DM * DM; jb.gain = nullptr; jb.WT = (bf16*)(base + MLA_WIN_B + MLA_WUQ_B + MLA_WUKV_B); jb.K = DM; jb.N = DM; }
    } else if (j < 38) { const int l = (j - 32) / 3, r = (j - 32) % 3; unsigned char* base = ws + WS_NSA + (size_t)l * NSA_B; jb.mode = 0;
        if (r == 0)      { jb.W = (const float*)a.in[I_NWIN] + (size_t)l * DM * NSA_IN; jb.gain = (const float*)a.in[I_MIXN] + (size_t)(2 + l) * DM; jb.WT = (bf16*)base; jb.K = DM; jb.N = 4096; jb.ldw = NSA_IN; }
        else if (r == 1) { jb.W = (const float*)a.in[I_NWIN] + (size_t)l * DM * NSA_IN + 4096; jb.gain = (const float*)a.in[I_MIXN] + (size_t)(2 + l) * DM; jb.WT = (bf16*)(base + NSA_WQ_B); jb.K = DM; jb.N = 96; jb.ldw = NSA_IN; jb.mode = 3; }
        else             { jb.W = (const float*)a.in[I_NWO] + (size_t)l * DM * DM; jb.gain = nullptr; jb.WT = (bf16*)(base + NSA_WIN_B); jb.K = DM; jb.N = DM; }
    } else if (j == 38) { jb.W = (const float*)a.in[I_KVW]; jb.gain = (const float*)a.in[I_KVN]; jb.WT = (bf16*)(ws + WS_KVW); jb.K = DM; jb.N = 2048; jb.ldw = NKV; jb.mode = 0; }
    else if (j == 41)   { jb.W = (const float*)a.in[I_KVW] + 2048; jb.gain = (const float*)a.in[I_KVN]; jb.WT = (bf16*)(ws + WS_KVW + (size_t)2048 * DM * 2); jb.K = DM; jb.N = 1024; jb.ldw = NKV; jb.mode = 4; }
    else if (j == 39)   { jb.W = (const float*)a.in[I_CKW1]; jb.gain = nullptr; jb.WT = (bf16*)(ws + WS_CW1); jb.K = 4096; jb.N = CMP_HID; jb.mode = 3; }
    else if (j == 40)   { jb.W = (const float*)a.in[I_CVW1]; jb.gain = nullptr; jb.WT = (bf16*)(ws + WS_CW1 + CW1_B); jb.K = 4096; jb.N = CMP_HID; jb.mode = 3; }
    if (jb.ldw == 0) jb.ldw = jb.N;
    return jb;
}
__device__ __forceinline__ void cvt_item(const float* W, const float* gain, bf16* WT, int K, int N, int ldw, int mode, LAS float* scr, int item, int lane) {
    const int nblk = N / 32, kb = item / nblk, nb = item - kb * nblk, k0 = 64 * kb, n0 = 32 * nb;
    float wv[32];
#pragma unroll
    for (int i = 0; i < 32; ++i) wv[i] = __builtin_nontemporal_load(&W[(size_t)(k0 + 2 * i + (lane >> 5)) * ldw + n0 + (lane & 31)]);
    if (gain) {
#pragma unroll
        for (int i = 0; i < 32; ++i) wv[i] *= gain[k0 + 2 * i + (lane >> 5)]; }
#pragma unroll
    for (int i = 0; i < 32; ++i) scr[(2 * i + (lane >> 5)) * 33 + (lane & 31)] = wv[i];
    LDS_WAIT(); asm volatile("" ::: "memory");
    const int c = lane & 7;
    const int drow0 = (mode == 0) ? n0 : (256 * (n0 >> 7) + (n0 & 127) + (mode == 2 ? 128 : 0));
#pragma unroll
    for (int j = 0; j < 4; ++j) { const int n = (lane >> 3) + 8 * j; const LAS float* s = scr + (8 * c) * 33 + n;
        u32x4 o; o.x = pk2(s[0 * 33], s[1 * 33]); o.y = pk2(s[2 * 33], s[3 * 33]); o.z = pk2(s[4 * 33], s[5 * 33]); o.w = pk2(s[6 * 33], s[7 * 33]);
        bf16* dst = (mode == 3) ? WT + (size_t)(k0 >> 9) * (256 * 512) + (size_t)(n0 + n) * 512 + (k0 & 511) + 8 * c
                  : (mode == 4) ? WT + (size_t)(k0 >> 11) * (1024 * 2048) + (size_t)(n0 + n) * 2048 + (k0 & 2047) + 8 * c : WT + (size_t)(drow0 + n) * K + k0 + 8 * c;
        *(GAS u32x4*)dst = o; }
    LDS_WAIT(); asm volatile("" ::: "memory");
}
__device__ __forceinline__ void cvt_load(float (&wv)[32], float& gv, const CvtJob& jb, int item, int lane) {
    const int nblk = jb.N / 32, kb = item / nblk, nb = item - kb * nblk, k0 = 64 * kb, n0 = 32 * nb;
    const float* p = jb.W + (size_t)(k0 + (lane >> 5)) * jb.ldw + n0 + (lane & 31);
#pragma unroll
    for (int i = 0; i < 32; ++i) wv[i] = __builtin_nontemporal_load(p + (size_t)(2 * i) * jb.ldw);
    gv = jb.gain ? jb.gain[k0 + lane] : 1.0f;
}
__device__ __forceinline__ void cvt_finish(float (&wv)[32], const float gv, const CvtJob& jb, int item, LAS float* scr, int lane) {
    const int nblk = jb.N / 32, kb = item / nblk, nb = item - kb * nblk, k0 = 64 * kb, n0 = 32 * nb, mode = jb.mode, K = jb.K;
    if (jb.gain) {
#pragma unroll
        for (int i = 0; i < 32; ++i) wv[i] *= __builtin_bit_cast(float, __builtin_amdgcn_ds_bpermute((2 * i + (lane >> 5)) * 4, __builtin_bit_cast(int, gv))); }
#pragma unroll
    for (int i = 0; i < 32; ++i) scr[(2 * i + (lane >> 5)) * 33 + (lane & 31)] = wv[i];
    LDS_WAIT(); asm volatile("" ::: "memory");
    const int c = lane & 7;
    const int drow0 = (mode == 0) ? n0 : (256 * (n0 >> 7) + (n0 & 127) + (mode == 2 ? 128 : 0));
#pragma unroll
    for (int j = 0; j < 4; ++j) { const int n = (lane >> 3) + 8 * j; const LAS float* s = scr + (8 * c) * 33 + n;
        u32x4 o; o.x = pk2(s[0 * 33], s[1 * 33]); o.y = pk2(s[2 * 33], s[3 * 33]); o.z = pk2(s[4 * 33], s[5 * 33]); o.w = pk2(s[6 * 33], s[7 * 33]);
        bf16* dst = (mode == 3) ? jb.WT + (size_t)(k0 >> 9) * (256 * 512) + (size_t)(n0 + n) * 512 + (k0 & 511) + 8 * c
                  : (mode == 4) ? jb.WT + (size_t)(k0 >> 11) * (1024 * 2048) + (size_t)(n0 + n) * 2048 + (k0 & 2047) + 8 * c : jb.WT + (size_t)(drow0 + n) * K + k0 + 8 * c;
        *(GAS u32x4*)dst = o; }
    LDS_WAIT(); asm volatile("" ::: "memory");
}
template <class ArgsT> __device__ __forceinline__ bool cvt_next(const ArgsT& a, int& j, const int jend, int& it, CvtJob& jb, const int gw) {
    while (j < jend) { jb = get_job(a, j); if (it < (jb.K / 64) * (jb.N / 32)) return true; ++j; it = gw; }
    return false;
}
template <class ArgsT> __device__ __forceinline__ void cvt_range(const ArgsT& a, const int j0, const int n, LAS unsigned char* lds, int gw, int NGW, int wave, int lane) {
    LAS float* scr = (LAS float*)(lds + wave * 16384);
    int j = j0, it = gw; const int jend = j0 + n; CvtJob ja, jb; float wa[32], wb[32], ga = 1.0f, gb = 1.0f;
    bool va = cvt_next(a, j, jend, it, ja, gw); int ita = it, itb = 0; if (va) cvt_load(wa, ga, ja, ita, lane);
    while (va) {
        it += NGW; const bool vb = cvt_next(a, j, jend, it, jb, gw); itb = it; if (vb) cvt_load(wb, gb, jb, itb, lane);
        cvt_finish(wa, ga, ja, ita, scr, lane);
        if (!vb) break;
        it += NGW; va = cvt_next(a, j, jend, it, ja, gw); ita = it; if (va) cvt_load(wa, ga, ja, ita, lane);
        cvt_finish(wb, gb, jb, itb, scr, lane);
    }
}
__device__ __forceinline__ void zero_fill16(void* p, size_t bytes, int gtid, int gthreads) {
    u32x4* q = (u32x4*)p; const size_t n = bytes / 16; const u32x4 z = {0u, 0u, 0u, 0u};
    for (size_t i = gtid; i < n; i += gthreads) q[i] = z;
}
template <class ArgsT> __device__ __forceinline__ void prologue(const ArgsT& a, LAS unsigned char* lds, int vcu, int G, int wave, int lane, int tid) {
    unsigned char* ws = a.ws;
    LAS float* scr = (LAS float*)(lds + wave * 16384);
    const int gw = vcu * NWAVES + wave, NGW = G * NWAVES, gtid = gw * 64 + lane, gthreads = NGW * 64;
    cvt_range(a, 0, 2, lds, gw, NGW, wave, lane);
    for (int l = 0; l < 2; ++l) {
        zero_fill16(ws + WS_MLA + (size_t)l * MLA_B + (size_t)MLA_IN * DM * 2, (size_t)(MLA_IN_P - MLA_IN) * DM * 2, gtid, gthreads);
        for (int s = 0; s < 8; ++s) zero_fill16(ws + WS_NSA + (size_t)l * NSA_B + NSA_WQ_B + (size_t)s * GSL_B + (size_t)96 * 512 * 2, (size_t)160 * 512 * 2, gtid, gthreads); }
    { const int* pos = (const int*)a.in[I_POS]; float* ta = (float*)(ws + WS_TABA); float* tb = (float*)(ws + WS_TABB);
      for (int i = gtid; i < T * 32; i += gthreads) { const int t = i >> 5, f = i & 31; const float inv = powf(10000.0f, -(float)(2 * f) / 64.0f); const float ang = (float)pos[t] * inv;
          float sn, cs; sincosf(ang, &sn, &cs); ta[i] = cs; ta[T * 32 + i] = sn; }
      for (int i = gtid; i < T * 64; i += gthreads) { const int t = i >> 6, f = i & 63; const float inv = powf(10000.0f, -(float)(2 * f) / 128.0f); const float ang = (float)pos[t] * inv;
          float sn, cs; sincosf(ang, &sn, &cs); tb[i] = cs; tb[T * 64 + i] = sn; } }
    { const float* x = (const float*)a.in[I_X]; bf16* hb = (bf16*)(ws + WS_HB); float* ss0 = (float*)(ws + SS_OFF);
      for (int m = gw; m < T; m += NGW) { const f32x4* xr = (const f32x4*)(x + (size_t)m * DM) + lane; u32x2* o8 = (u32x2*)(hb + (size_t)m * DM) + lane; float s = 0.f;
#pragma unroll 4
          for (int j = 0; j < 16; ++j) { const f32x4 v = __builtin_nontemporal_load(&xr[64 * j]); s += pg8::quad_sq(v); u32x2 w; w.x = pk2(v[0], v[1]); w.y = pk2(v[2], v[3]); o8[64 * j] = w; }
          s = wave_sum(s, lane); if (lane == 0) ss0[(size_t)m * 64] = s; } }
}

constexpr float QS_MLA = 0.07216878364870322f * LOG2E;
constexpr float QS_NSA = 0.08838834764831845f * LOG2E;
__device__ __forceinline__ void unpack8(const u32x4 w, float (&v)[8]) {
    v[0] = __builtin_bit_cast(float, w.x << 16); v[1] = __builtin_bit_cast(float, w.x & 0xffff0000u); v[2] = __builtin_bit_cast(float, w.y << 16); v[3] = __builtin_bit_cast(float, w.y & 0xffff0000u);
    v[4] = __builtin_bit_cast(float, w.z << 16); v[5] = __builtin_bit_cast(float, w.z & 0xffff0000u); v[6] = __builtin_bit_cast(float, w.w << 16); v[7] = __builtin_bit_cast(float, w.w & 0xffff0000u);
}
__device__ __forceinline__ u32x4 pack8(const float (&v)[8]) { u32x4 w; w.x = cvt_pk_bf16(v[0], v[1]); w.y = cvt_pk_bf16(v[2], v[3]); w.z = cvt_pk_bf16(v[4], v[5]); w.w = cvt_pk_bf16(v[6], v[7]); return w; }
__device__ __forceinline__ void mla_k_finalize(const bf16* kvraw, const bf16* cbuf, const float* gk, const float* tabA, bf16* Kf, int gw, int NGW, int lane) {
    const int hd8 = lane >> 3, c = lane & 7;
    float g0[8], g1[8], g2[8];
#pragma unroll
    for (int i = 0; i < 8; ++i) { g0[i] = gk[c * 16 + i]; g1[i] = gk[c * 16 + 8 + i]; g2[i] = gk[128 + c * 8 + i]; }
    for (int it = gw; it < T * 4; it += NGW) { const int tok = it >> 2, head = (it & 3) * 8 + hd8;
        const bf16* kp = kvraw + (size_t)tok * 8192 + head * 256 + c * 16;
        const u32x4 w0 = *(const u32x4*)kp, w1 = *(const u32x4*)(kp + 8), wr = *(const u32x4*)(cbuf + (size_t)tok * MLA_IN_P + 1536 + c * 8);
        const f32x4 cs0 = *(const f32x4*)(tabA + tok * 32 + 8 * (c & 3)), cs1 = *(const f32x4*)(tabA + tok * 32 + 8 * (c & 3) + 4);
        const f32x4 sn0 = *(const f32x4*)(tabA + T * 32 + tok * 32 + 8 * (c & 3)), sn1 = *(const f32x4*)(tabA + T * 32 + tok * 32 + 8 * (c & 3) + 4);
        float a[8], bq[8], r8[8]; unpack8(w0, a); unpack8(w1, bq); unpack8(wr, r8);
        float ss = 0.f;
#pragma unroll
        for (int i = 0; i < 8; ++i) ss += a[i] * a[i] + bq[i] * bq[i] + r8[i] * r8[i];
        ss += shx(ss, 1, lane); ss += shx(ss, 2, lane); ss += shx(ss, 4, lane);
        const float r = __builtin_amdgcn_rsqf(ss * (1.0f / 192.0f) + EPS);
        float o[8];
#pragma unroll
        for (int i = 0; i < 8; ++i) { a[i] *= r * g0[i]; bq[i] *= r * g1[i]; r8[i] *= r * g2[i]; }
#pragma unroll
        for (int i = 0; i < 8; ++i) { const float p = shx(r8[i], 4, lane); const float cs = i < 4 ? cs0[i & 3] : cs1[i & 3], sn = i < 4 ? sn0[i & 3] : sn1[i & 3];
            o[i] = (c < 4) ? (r8[i] * cs - p * sn) : (r8[i] * cs + p * sn); }
        bf16* op = Kf + ((size_t)tok * 32 + head) * 192;
        *(u32x4*)(op + c * 16) = pack8(a); *(u32x4*)(op + c * 16 + 8) = pack8(bq); *(u32x4*)(op + 128 + c * 8) = pack8(o);
    }
}
__device__ __forceinline__ void ld16f(float (&x)[16], const float* p) {
#pragma unroll
    for (int q = 0; q < 4; ++q) { const f32x4 v = *(const f32x4*)(p + 4 * q); x[4 * q] = v[0]; x[4 * q + 1] = v[1]; x[4 * q + 2] = v[2]; x[4 * q + 3] = v[3]; } }
__device__ __forceinline__ void st16bf(bf16* p, const float (&x)[16]) {
    u32x4 a, c2; a.x = cvt_pk_bf16(x[0], x[1]); a.y = cvt_pk_bf16(x[2], x[3]); a.z = cvt_pk_bf16(x[4], x[5]); a.w = cvt_pk_bf16(x[6], x[7]);
    c2.x = cvt_pk_bf16(x[8], x[9]); c2.y = cvt_pk_bf16(x[10], x[11]); c2.z = cvt_pk_bf16(x[12], x[13]); c2.w = cvt_pk_bf16(x[14], x[15]);
    *(u32x4*)p = a; *(u32x4*)(p + 8) = c2; }
template <class ArgsT> __device__ __forceinline__ void nsa_kv_finalize(const ArgsT& a, int gw, int NGW, int lane) {
    unsigned char* ws = a.ws; const float* kvs = (const float*)(ws + WS_KVS); const float* tabB = (const float*)(ws + WS_TABB);
    bf16* Ks = (bf16*)(ws + WS_KSLC); bf16* Kw = (bf16*)(ws + WS_KWIN); bf16* Vs = (bf16*)(ws + WS_VSLC); bf16* Vw = (bf16*)(ws + WS_VWIN);
    const int v = lane >> 3, c = lane & 7, g = v & 3; const bool win = v >= 4;
    float gn[16]; ld16f(gn, (const float*)a.in[win ? I_GKW : I_GKS] + c * 16);
    for (int tok = gw; tok < T; tok += NGW) { const float* row = kvs + (size_t)tok * NKV; const size_t o = (size_t)tok * 512 + g * 128 + c * 16;
        const float* wp = (const float*)(ws + WS_ACT) + (size_t)tok * 1024 + g * 128 + c * 16;
        float x[16], cs[16], sn[16];
        if (win) { float x2[16]; ld16f(x, wp); ld16f(x2, wp + (size_t)T * 1024);
#pragma unroll
            for (int i = 0; i < 16; ++i) x[i] += x2[i]; }
        else ld16f(x, row + 2 * 512 + g * 128 + c * 16); ld16f(cs, tabB + tok * 64 + (c & 3) * 16); ld16f(sn, tabB + T * 64 + tok * 64 + (c & 3) * 16);
        float ss = 0.f;
#pragma unroll
        for (int i = 0; i < 16; ++i) ss += x[i] * x[i];
        ss += shx(ss, 1, lane); ss += shx(ss, 2, lane); ss += shx(ss, 4, lane);
        const float r = __builtin_amdgcn_rsqf(ss * (1.0f / 128.0f) + EPS);
#pragma unroll
        for (int i = 0; i < 16; ++i) { x[i] *= r * gn[i]; const float p = shx(x[i], 4, lane); x[i] = (c < 4) ? (x[i] * cs[i] - p * sn[i]) : (x[i] * cs[i] + p * sn[i]); }
        st16bf((win ? Kw : Ks) + o, x);
        float y[16];
        if (win) { float y2[16]; ld16f(y, wp + 512); ld16f(y2, wp + 512 + (size_t)T * 1024);
#pragma unroll
            for (int i = 0; i < 16; ++i) y[i] += y2[i]; }
        else ld16f(y, row + 3 * 512 + g * 128 + c * 16);
        st16bf((win ? Vw : Vs) + o, y);
    }
    bf16* bk = (bf16*)(ws + WS_BLKK); bf16* bv = (bf16*)(ws + WS_BLKV); const float* pk = (const float*)a.in[I_CPK]; const float* pv = (const float*)a.in[I_CPV];
    for (int rho = gw; rho < CMP_ROWS_P; rho += NGW) {
        if (rho < CMP_ROWS) { const int b = rho / (NCMP * NSA_G), rem = rho - b * (NCMP * NSA_G), n = rem >> 2, gg = rem & 3;
            for (int l0 = 0; l0 < 32; l0 += 8) { const int l = l0 + v; const float* row = kvs + (size_t)(b * SEQ + 16 * n + l) * NKV + gg * 128 + c * 16; const size_t o = (size_t)rho * 4096 + l * 128 + c * 16;
                float x[16], p[16]; ld16f(x, row); ld16f(p, pk + l * 128 + c * 16);
#pragma unroll
                for (int i = 0; i < 16; ++i) x[i] += p[i];
                st16bf(bk + o, x);
                ld16f(x, row + 512); ld16f(p, pv + l * 128 + c * 16);
#pragma unroll
                for (int i = 0; i < 16; ++i) x[i] += p[i];
                st16bf(bv + o, x); }
        } else { const u32x4 z = {0u, 0u, 0u, 0u}; for (int c8 = lane; c8 < 512; c8 += 64) { *(u32x4*)(bk + (size_t)rho * 4096 + c8 * 8) = z; *(u32x4*)(bv + (size_t)rho * 4096 + c8 * 8) = z; } }
    }
}
template <class ArgsT> __device__ __forceinline__ void nsa_cmp_out(const ArgsT& a, LAS unsigned char* lds, int gw, int NGW, int wave, int lane) {
    unsigned char* ws = a.ws; const float* P = (const float*)(ws + WS_KVS); bf16* Kc = (bf16*)(ws + WS_KC); bf16* Vc = (bf16*)(ws + WS_VC);
    const float* w2k = (const float*)a.in[I_CKW2]; const float* w2v = (const float*)a.in[I_CVW2]; const float* gkc = (const float*)a.in[I_GKC];
    const float* b1k = (const float*)a.in[I_CKB1]; const float* b1v = (const float*)a.in[I_CVB1];
    LAS float* hs = (LAS float*)(lds + wave * 4096);
    for (int rho = gw; rho < CMP_ROWS; rho += NGW) {
#pragma unroll
        for (int i = 0; i < 4; ++i) { const int j = lane + 64 * i; float sk = b1k[j], sv = b1v[j];
#pragma unroll
            for (int s = 0; s < 8; ++s) { sk += P[((size_t)s * CMP_ROWS_P + rho) * 256 + j]; sv += P[((size_t)(8 + s) * CMP_ROWS_P + rho) * 256 + j]; }
            hs[j] = pg8::silu_f(sk); hs[256 + j] = pg8::silu_f(sv); }
        LDS_WAIT(); asm volatile("" ::: "memory");
        float k0 = 0.f, k1 = 0.f, v0 = 0.f, v1 = 0.f;
#pragma unroll 8
        for (int j = 0; j < CMP_HID; ++j) { const float xk = hs[j], xv = hs[256 + j];
            k0 += xk * w2k[j * 128 + lane]; k1 += xk * w2k[j * 128 + 64 + lane]; v0 += xv * w2v[j * 128 + lane]; v1 += xv * w2v[j * 128 + 64 + lane]; }
        const float r = __builtin_amdgcn_rsqf(wave_sum(k0 * k0 + k1 * k1, lane) * (1.0f / 128.0f) + EPS);
        const int b = rho / (NCMP * NSA_G), rem = rho - b * (NCMP * NSA_G), n = rem >> 2, g = rem & 3; const size_t o = ((size_t)(b * 4 + g) * 128 + n) * 128;
        Kc[o + lane] = (bf16)f2bf(k0 * r * gkc[lane]); Kc[o + 64 + lane] = (bf16)f2bf(k1 * r * gkc[64 + lane]); Vc[o + lane] = (bf16)f2bf(v0); Vc[o + 64 + lane] = (bf16)f2bf(v1);
        LDS_WAIT(); asm volatile("" ::: "memory"); }
    for (int i = gw; i < 16; i += NGW) { const size_t o = ((size_t)i * 128 + 127) * 128; Kc[o + lane] = 0; Kc[o + 64 + lane] = 0; Vc[o + lane] = 0; Vc[o + 64 + lane] = 0; }
}
#ifndef MK_SENS
#define MK_SENS 0
#endif
struct AttnSt { f32x16 o[4]; float m, l; };
template <int DQK> struct ACfg { static constexpr int KSTR = DQK * 2 + 16, KBYTES = 64 * KSTR, VSTR = 320, VBYTES = 64 * VSTR, STAGE = KBYTES + VBYTES, NCK = DQK / 64, NSTEP = DQK / 16,
    KCH = KSTR / 16, VCH = VSTR / 16, NDMA = KCH + VCH  , NI = (NDMA + 7) / 8  ; };
typedef short v4i16_t __attribute__((ext_vector_type(4)));
__device__ __forceinline__ s16x4 vtr(const LAS unsigned char* p) { return __builtin_bit_cast(s16x4, __builtin_amdgcn_ds_read_tr16_b64_v4i16((LAS v4i16_t*)p)); }
__device__ __forceinline__ float xmax32(float x) { float a = x, c = x; asm volatile("s_nop 1\n\tv_permlane32_swap_b32 %0, %1" : "+v"(a), "+v"(c)); return fmaxf(a, c); }
__device__ __forceinline__ float xsum32(float x) { float a = x, c = x; asm volatile("s_nop 1\n\tv_permlane32_swap_b32 %0, %1" : "+v"(a), "+v"(c)); return a + c; }
typedef float f32x2_t __attribute__((ext_vector_type(2))); typedef __bf16 bf16x2_t __attribute__((ext_vector_type(2)));
__device__ __forceinline__ unsigned cvtpk(float lo, float hi) { const f32x2_t v = {lo, hi}; return __builtin_bit_cast(unsigned, __builtin_convertvector(v, bf16x2_t)); }
__device__ __forceinline__ int relane(int v) { asm volatile("" : "+v"(v)); return v; }
__device__ __forceinline__ void attn_init(AttnSt& st) {
#pragma unroll
    for (int d = 0; d < 4; ++d)
#pragma unroll
        for (int r = 0; r < 16; ++r) st.o[d][r] = 0.f;
    st.m = NEGF; st.l = 0.f;
}
template <int DQK> __device__ __forceinline__ void tile_offsets(unsigned (&off)[ACfg<DQK>::NI], unsigned krow, unsigned vrow, int wave, int lane) {
    using C = ACfg<DQK>;
#pragma unroll
    for (int j = 0; j < C::NI; ++j) { const int i = wave + 8 * j;
        if (i < C::KCH) { const int s = i * 64 + lane, r = s / C::KCH; int cc = s - r * C::KCH; cc = cc < DQK / 8 ? cc : 0; off[j] = (unsigned)r * krow * 2u + (unsigned)cc * 16u; }
        else { const int s = (i - C::KCH) * 64 + lane, r = (s / C::VCH) & 63; int cc = s % C::VCH; cc = cc < 16 ? cc : 0; off[j] = (unsigned)r * vrow * 2u + (unsigned)cc * 16u; } }
}
template <int DQK> __device__ __forceinline__ void tile_dma(LAS unsigned char* tb, const bf16* Kt, const bf16* Vt, const unsigned (&off)[ACfg<DQK>::NI], int wave) {
    using C = ACfg<DQK>;
#pragma unroll
    for (int j = 0; j < C::NI; ++j) { const int i = wave + 8 * j;
        if (i < C::KCH) __builtin_amdgcn_global_load_lds((const unsigned*)((const char*)Kt + off[j]), (LAS unsigned*)(tb + i * 1024), 16, 0, 0);
        else if (i < C::NDMA) __builtin_amdgcn_global_load_lds((const unsigned*)((const char*)Vt + off[j]), (LAS unsigned*)(tb + C::KBYTES + (i - C::KCH) * 1024), 16, 0, 0); }
}
#define DMA_WAIT_SYNC() do { asm volatile("s_waitcnt vmcnt(0)" ::: "memory"); __syncthreads(); } while (0)
template <int DQK> __device__ __forceinline__ void tile_scores(f32x16& s0, f32x16& s1, const bf16x8 (&qf)[DQK / 16], const LAS unsigned char* tb, const float c0  , int lane) {
    using C = ACfg<DQK>;
    const LAS unsigned char* kp = tb + (lane & 31) * C::KSTR + (lane >> 5) * 16;
#pragma unroll
    for (int r = 0; r < 16; ++r) { s0[r] = c0; s1[r] = c0; }
    bf16x8 kf[3][2];
    kf[0][0] = *(const LAS bf16x8*)(kp); kf[0][1] = *(const LAS bf16x8*)(kp + 32 * C::KSTR);
    kf[1][0] = *(const LAS bf16x8*)(kp + 32); kf[1][1] = *(const LAS bf16x8*)(kp + 32 * C::KSTR + 32);
    __builtin_amdgcn_sched_barrier(0);
#pragma unroll
    for (int st = 0; st < C::NSTEP; ++st) {
        if (st + 2 < C::NSTEP) { kf[(st + 2) % 3][0] = *(const LAS bf16x8*)(kp + (st + 2) * 32); kf[(st + 2) % 3][1] = *(const LAS bf16x8*)(kp + 32 * C::KSTR + (st + 2) * 32); }
        s0 = __builtin_amdgcn_mfma_f32_32x32x16_bf16(kf[st % 3][0], qf[st], s0, 0, 0, 0); s1 = __builtin_amdgcn_mfma_f32_32x32x16_bf16(kf[st % 3][1], qf[st], s1, 0, 0, 0);
        __builtin_amdgcn_sched_barrier(0); }
}
__device__ __forceinline__ bf16x8 exp_pack8(const f32x16& s, int base, float& rs) {
    float e[8];
#pragma unroll
    for (int j = 0; j < 8; ++j) { e[j] = __builtin_amdgcn_exp2f(s[base + j]); rs += e[j]; }
    u32x4 w; w.x = cvtpk(e[0], e[1]); w.y = cvtpk(e[2], e[3]); w.z = cvtpk(e[4], e[5]); w.w = cvtpk(e[6], e[7]);
    return __builtin_bit_cast(bf16x8, w);
}
template <int DQK> __device__ __forceinline__ void tile_compute(AttnSt& st, const bf16x8 (&qf)[DQK / 16], const LAS unsigned char* tb, int key0, int lo, int hi, int mode  , int lane) {
    using C = ACfg<DQK>; const int h = lane >> 5;
    const bool lane_off = (mode == 1) && (hi < 0);
    const bool fresh = (st.m == NEGF); const float ref = fresh ? 0.f : st.m;
    f32x16 s0, s1; tile_scores<DQK>(s0, s1, qf, tb, lane_off ? -3.0e38f : -ref, lane);
    float mx;
    if (mode == 2) {
#pragma unroll
        for (int r = 0; r < 16; ++r) { const int k0 = key0 + (r & 3) + 8 * (r >> 2) + 4 * h, k1 = k0 + 32;
            s0[r] = (k0 >= lo && k0 <= hi) ? s0[r] : NEGF; s1[r] = (k1 >= lo && k1 <= hi) ? s1[r] : NEGF; }
    }
    mx = fmaxf(s0[15], s1[15]);
#pragma unroll
    for (int r = 0; r < 15; ++r) asm("v_max3_f32 %0, %1, %2, %3" : "=v"(mx) : "v"(mx), "v"(s0[r]), "v"(s1[r]));
    mx = lane_off ? NEGF : mx;
    mx = xmax32(mx);
    constexpr float RESCALE_THR = 8.0f;
    float rs = 0.f;
    if (__builtin_amdgcn_ballot_w64(fresh ? (mx > 0.5f * NEGF) : (mx > RESCALE_THR)) != 0ull) {
        const float mt = (mx > 0.5f * NEGF) ? mx + ref : NEGF, mn = fmaxf(st.m, mt), delta = (mn == NEGF || lane_off) ? 0.f : mn - ref;
        const float alpha = __builtin_amdgcn_exp2f(st.m - mn); st.l *= alpha;
#pragma unroll
        for (int d = 0; d < 4; ++d) st.o[d] = st.o[d] * alpha;
#pragma unroll
        for (int r = 0; r < 16; ++r) { s0[r] -= delta; s1[r] -= delta; }
        st.m = mn; }
    const LAS unsigned char* vp = tb + C::KBYTES + (4 * h + ((lane & 15) >> 2)) * C::VSTR + (((lane >> 4) & 1) * 16 + (lane & 3) * 4) * 2;
#define VFRAG(i) __builtin_shufflevector(vtr(vp + (16 * ((i) >> 2)) * C::VSTR + ((i) & 3) * 64), vtr(vp + (16 * ((i) >> 2) + 8) * C::VSTR + ((i) & 3) * 64), 0, 1, 2, 3, 4, 5, 6, 7)
    bf16x8 vf[4]; vf[0] = VFRAG(0); vf[1] = VFRAG(1); vf[2] = VFRAG(2);
    bf16x8 pb[2]; pb[0] = exp_pack8(s0, 0, rs);
    __builtin_amdgcn_sched_barrier(0);
#pragma unroll
    for (int ks = 0; ks < 4; ++ks) {
#pragma unroll
        for (int d = 0; d < 4; ++d) { const int i = 4 * ks + d;
            if (i + 3 < 16) vf[(i + 3) & 3] = VFRAG(i + 3);
            st.o[d] = __builtin_amdgcn_mfma_f32_32x32x16_bf16(vf[i & 3], pb[ks & 1], st.o[d], 0, 0, 0); }
#if MK_SENS == 1
        { const u32x4 zz = {0u, 0u, 0u, 0u}; const bf16x8 zf = __builtin_bit_cast(bf16x8, zz);
#pragma unroll
          for (int d = 0; d < 4; ++d) st.o[d] = __builtin_amdgcn_mfma_f32_32x32x16_bf16(vf[d], zf, st.o[d], 0, 0, 0); }
#endif
        __builtin_amdgcn_sched_barrier(0);
        if (ks < 3) { pb[(ks + 1) & 1] = exp_pack8(ks + 1 < 2 ? s0 : s1, 8 * ((ks + 1) & 1), rs); __builtin_amdgcn_sched_barrier(0); } }
#undef VFRAG
#if MK_SENS == 2
#pragma unroll
    for (int r = 0; r < 16; ++r) rs += __builtin_amdgcn_exp2f(s0[r] - 1000.f) + __builtin_amdgcn_exp2f(s1[r] - 1000.f);
#endif
    st.l += xsum32(rs);
}
template <int DQK> __device__ __forceinline__ void attn_pass(AttnSt& st, const bf16x8 (&qf)[DQK / 16], LAS unsigned char* lds, const bf16* Kg, unsigned krow, const bf16* Vg, unsigned vrow,
                                                         unsigned tilemask, unsigned selbits, unsigned selall, int lo, int hi, int wlo, int whi, int ilo, int ihi, int tid, int lane) {
    using C = ACfg<DQK>;
    unsigned rem = (unsigned)__builtin_amdgcn_readfirstlane((int)tilemask); if (rem == 0u) return;
    int kt = __builtin_ctz(rem); rem &= rem - 1u;
    unsigned off[C::NI]; const int wave = __builtin_amdgcn_readfirstlane(tid >> 6); tile_offsets<DQK>(off, krow, vrow, wave, lane);
    tile_dma<DQK>(lds, Kg + (size_t)kt * 64 * krow, Vg + (size_t)kt * 64 * vrow, off, wave);
    DMA_WAIT_SYNC();
    int buf = 0;
    for (;;) {
        const bool more = rem != 0u; int ktn = 0;
        if (more) { ktn = __builtin_ctz(rem); rem &= rem - 1u; tile_dma<DQK>(lds + (buf ^ 1) * C::STAGE, Kg + (size_t)ktn * 64 * krow, Vg + (size_t)ktn * 64 * vrow, off, wave); }
        if (kt * 64 <= whi && kt * 64 + 63 >= wlo) tile_compute<DQK>(st, qf, lds + buf * C::STAGE, kt * 64, lo, ((selbits >> kt) & 1u) ? hi : -1, (kt * 64 >= ilo && kt * 64 + 63 <= ihi) ? (((selall >> kt) & 1u) ? 0 : 1) : 2, lane);
        DMA_WAIT_SYNC();
        if (!more) break;
        kt = ktn; buf ^= 1;
    }
}

__device__ __forceinline__ float sumsq8(const u32x4 w) { float v[8]; unpack8(w, v); return ((v[0] * v[0] + v[1] * v[1]) + (v[2] * v[2] + v[3] * v[3])) + ((v[4] * v[4] + v[5] * v[5]) + (v[6] * v[6] + v[7] * v[7])); }
__device__ __forceinline__ void scaled8(float (&v)[8], const u32x4 w, float r, const float* g) { unpack8(w, v); const f32x4 ga = *(const f32x4*)g, gb = *(const f32x4*)(g + 4);
#pragma unroll
    for (int j = 0; j < 8; ++j) v[j] *= r * (j < 4 ? ga[j & 3] : gb[j & 3]); }
__device__ __forceinline__ void rope8(float (&x1)[8], float (&x2)[8], const float* cs_p, const float* sn_p) { const f32x4 ca = *(const f32x4*)cs_p, cb = *(const f32x4*)(cs_p + 4), sa = *(const f32x4*)sn_p, sb = *(const f32x4*)(sn_p + 4);
#pragma unroll
    for (int j = 0; j < 8; ++j) { const float cs = j < 4 ? ca[j & 3] : cb[j & 3], sn = j < 4 ? sa[j & 3] : sb[j & 3], a = x1[j], b2 = x2[j]; x1[j] = a * cs - b2 * sn; x2[j] = b2 * cs + a * sn; } }
__device__ __forceinline__ bf16x8 packs8(float (&v)[8], float sc) {
#pragma unroll
    for (int j = 0; j < 8; ++j) v[j] *= sc;
    return __builtin_bit_cast(bf16x8, pack8(v)); }
__device__ __forceinline__ void mla_load_q(bf16x8 (&qf)[12], const bf16* qrow, const float* gq, const float* tabA_row, int h, int lane) {
    u32x4 w[12]; float ss = 0.f;
#pragma unroll
    for (int s = 0; s < 12; ++s) { w[s] = *(const u32x4*)(qrow + 16 * s + 8 * h); ss += sumsq8(w[s]); }
    ss += shx(ss, 32, lane); const float r = __builtin_amdgcn_rsqf(ss * (1.0f / 192.0f) + EPS);
#pragma unroll
    for (int s = 0; s < 8; ++s) { float v[8]; scaled8(v, w[s], r, gq + 16 * s + 8 * h); qf[s] = packs8(v, QS_MLA); }
#pragma unroll
    for (int s = 8; s < 10; ++s) { float x1[8], x2[8]; scaled8(x1, w[s], r, gq + 16 * s + 8 * h); scaled8(x2, w[s + 2], r, gq + 16 * (s + 2) + 8 * h);
        const int i0 = 16 * (s - 8) + 8 * h; rope8(x1, x2, tabA_row + i0, tabA_row + T * 32 + i0); qf[s] = packs8(x1, QS_MLA); qf[s + 2] = packs8(x2, QS_MLA); }
}
template <bool ROPE> __device__ __forceinline__ void nsa_load_q(bf16x8 (&qf)[8], const bf16* qrow, const float* gq, const float* tabB_row, int h, int lane) {
    u32x4 w[8]; float ss = 0.f;
#pragma unroll
    for (int s = 0; s < 8; ++s) { w[s] = *(const u32x4*)(qrow + 16 * s + 8 * h); ss += sumsq8(w[s]); }
    ss += shx(ss, 32, lane); const float r = __builtin_amdgcn_rsqf(ss * (1.0f / 128.0f) + EPS);
#pragma unroll
    for (int s = 0; s < 4; ++s) { float x1[8], x2[8]; scaled8(x1, w[s], r, gq + 16 * s + 8 * h); scaled8(x2, w[s + 4], r, gq + 16 * (s + 4) + 8 * h);
        if (ROPE) { const int i0 = 16 * s + 8 * h; rope8(x1, x2, tabB_row + i0, tabB_row + T * 64 + i0); }
        qf[s] = packs8(x1, QS_NSA); qf[s + 4] = packs8(x2, QS_NSA); }
}

template <bool RMW> __device__ __forceinline__ void attn_out16(const AttnSt& st, float sc, bf16* rowp  , int h) {
#pragma unroll
    for (int d = 0; d < 4; ++d)
#pragma unroll
        for (int k = 0; k < 2; ++k) { float e[4], o[4];
#pragma unroll
            for (int i = 0; i < 4; ++i) { e[i] = st.o[d][8 * k + i] * sc; o[i] = st.o[d][8 * k + 4 + i] * sc; asm volatile("s_nop 1\n\tv_permlane32_swap_b32 %0, %1" : "+v"(e[i]), "+v"(o[i])); }
            bf16* p = rowp + 32 * d + 8 * (2 * k + h);
            if (RMW) { float v[8]; unpack8(*(const u32x4*)p, v);
#pragma unroll
                for (int i = 0; i < 4; ++i) { e[i] += v[i]; o[i] += v[4 + i]; } }
            u32x4 w; w.x = cvt_pk_bf16(e[0], e[1]); w.y = cvt_pk_bf16(e[2], e[3]); w.z = cvt_pk_bf16(o[0], o[1]); w.w = cvt_pk_bf16(o[2], o[3]);
            *(u32x4*)p = w; }
}

__device__ __forceinline__ void mla_attn_unit(int b, int hd, int qb, const bf16* Qraw, const float* gq, const float* tabA, const bf16* Kf, const bf16* KVraw, bf16* OB, LAS unsigned char* lds, int tid, int lane, int wave) {
    const int r32 = lane & 31, h = lane >> 5, q = qb * 256 + wave * 32 + r32; const size_t tok = (size_t)b * SEQ + q;
    bf16x8 qf[12]; mla_load_q(qf, Qraw + tok * 6144 + hd * 192, gq, tabA + tok * 32, h, lane);
    AttnSt st; attn_init(st);
    const int ntiles = 4 * qb + 4; const unsigned tilemask = ntiles >= 32 ? 0xffffffffu : ((1u << ntiles) - 1u);
    attn_pass<192>(st, qf, lds, Kf + ((size_t)b * SEQ * 32 + hd) * 192, 32u * 192u, KVraw + (size_t)b * SEQ * 8192 + hd * 256 + 128, 8192u,
                   tilemask, 0xffffffffu, 0xffffffffu, 0, q, 0, qb * 256 + wave * 32 + 31, 0, qb * 256 + wave * 32, tid, lane);
    const int l2 = relane(lane); const size_t tok2 = (size_t)b * SEQ + qb * 256 + wave * 32 + (l2 & 31);
    attn_out16<false>(st, 1.0f / st.l, OB + tok2 * DM + hd * 128, l2 >> 5);
}

__device__ __forceinline__ f32x4 ld4bf(const bf16* p) { const u32x2 w = *(const u32x2*)p; return (f32x4){__builtin_bit_cast(float, w.x << 16), __builtin_bit_cast(float, w.x & 0xffff0000u), __builtin_bit_cast(float, w.y << 16), __builtin_bit_cast(float, w.y & 0xffff0000u)}; }
__device__ __forceinline__ void st4bf(bf16* p, float a, float b, float c, float d) { u32x2 w; w.x = cvt_pk_bf16(a, b); w.y = cvt_pk_bf16(c, d); *(u32x2*)p = w; }
constexpr int IMP_OFF = 2 * ACfg<128>::STAGE, IMP_SLICE = 32 * 33 * 4, IMP2_OFF = IMP_OFF + NWAVES * IMP_SLICE;
static_assert(IMP2_OFF + 32 * 36 * 4 <= RING_BYTES && 2 * ACfg<192>::STAGE <= RING_BYTES, "attention LDS");
__device__ __forceinline__ void nsa_cmp_unit(int b, int g, int tt, const bf16* Qraw, const float* gq, const bf16* Kc, const bf16* Vc, const float* GP, const float* bgate, float* gates, bf16* oacc, unsigned* SEL, LAS unsigned char* lds, int tid, int lane, int wave) {
    const int r32 = lane & 31, h = lane >> 5, t0 = tt * 32, t = t0 + r32, head = g * 8 + wave; const size_t tok = (size_t)b * SEQ + t;
    bf16x8 qf[8]; nsa_load_q<false>(qf, Qraw + tok * 4096 + head * 128, gq, nullptr, h, lane);
    const int nvalid = t >= 31 ? ((t - 31) >> 4) + 1 : 0;
    AttnSt st; attn_init(st);
    const bf16* Kg = Kc + (size_t)(b * 4 + g) * 128 * 128; const bf16* Vg = Vc + (size_t)(b * 4 + g) * 128 * 128;
    LAS float* imp = (LAS float*)(lds + IMP_OFF + wave * IMP_SLICE); LAS float* imp2 = (LAS float*)(lds + IMP2_OFF);
    attn_pass<128>(st, qf, lds, Kg, 128u, Vg, 128u, 3u, 0xffffffffu, 0xffffffffu, 0, nvalid - 1, 0, t0 >> 4, 0, (t0 >= 31 ? ((t0 - 31) >> 4) : -1), tid, lane);
    const float invl = nvalid > 0 ? 1.0f / st.l : 0.f;
    { const int l2 = relane(lane); const size_t tok2 = (size_t)b * SEQ + t0 + (l2 & 31);
      float g3[3];
      { struct F3 { float x, y, z; }; float s0g = bgate[head * 3], s1g = bgate[head * 3 + 1], s2g = bgate[head * 3 + 2];
#pragma unroll
        for (int ks = 0; ks < 8; ++ks) { const F3 v = *(const F3*)(GP + ((size_t)ks * T + tok2) * 96 + head * 3); s0g += v.x; s1g += v.y; s2g += v.z; }
        g3[0] = pg8::sigmoid_f(s0g); g3[1] = pg8::sigmoid_f(s1g); g3[2] = pg8::sigmoid_f(s2g); }
      if ((l2 >> 5) == 0) { gates[tok2 * 96 + head * 3 + 0] = g3[0]; gates[tok2 * 96 + head * 3 + 1] = g3[1]; gates[tok2 * 96 + head * 3 + 2] = g3[2]; }
      attn_out16<false>(st, invl * g3[0], oacc + tok2 * 4096 + head * 128, l2 >> 5); }
    { float Bv[16];
#pragma unroll
      for (int tl = 0; tl < 2; ++tl) { f32x16 s0, s1; tile_scores<128>(s0, s1, qf, lds + tl * ACfg<128>::STAGE, 0.f, lane);
#pragma unroll
          for (int kb = 0; kb < 2; ++kb)
#pragma unroll
              for (int gq = 0; gq < 4; ++gq) { float P[4];
#pragma unroll
                  for (int i = 0; i < 4; ++i) { const int n = 64 * tl + 32 * kb + 8 * gq + 4 * h + i; const float sv = kb ? s1[4 * gq + i] : s0[4 * gq + i]; P[i] = (n < nvalid) ? __builtin_amdgcn_exp2f(sv - st.m) * invl : 0.f; }
                  const int jp = 16 * tl + 8 * kb + 2 * gq + h;
                  imp[r32 * 33 + jp] = 2.0f * (P[0] + P[1] + P[2]) + P[3]; Bv[tl * 8 + kb * 4 + gq] = P[3]; } }
      LDS_WAIT(); asm volatile("" ::: "memory");
#pragma unroll
      for (int tl = 0; tl < 2; ++tl)
#pragma unroll
          for (int kb = 0; kb < 2; ++kb)
#pragma unroll
              for (int gq = 0; gq < 4; ++gq) { const int jp = 16 * tl + 8 * kb + 2 * gq + h; imp[r32 * 33 + jp + 1] += Bv[tl * 8 + kb * 4 + gq]; } }
    __syncthreads();
    { const int tl = tid >> 4, jj = (tid & 15) * 2, tq = t0 + tl, cur = tq >> 6; float mine[2]; bool valid[2];
#pragma unroll
      for (int e = 0; e < 2; ++e) { const int j = jj + e; const bool forced = (j == 0) || (j == cur) || (j == cur - 1); valid[e] = j <= cur;
          float sum = 0.f;
#pragma unroll
          for (int w = 0; w < NWAVES; ++w) sum += ((const LAS float*)(lds + IMP_OFF + w * IMP_SLICE))[tl * 33 + j];
          mine[e] = forced ? 1e6f : (valid[e] ? sum : -1.0f); imp2[tl * 36 + j] = mine[e]; }
      __syncthreads();
      unsigned bits = 0u;
      int cnt0 = 0, cnt1 = 0;
#pragma unroll
      for (int i4 = 0; i4 < 8; ++i4) { const f32x4 xv = *(const LAS f32x4*)(imp2 + tl * 36 + 4 * i4);
#pragma unroll
          for (int q = 0; q < 4; ++q) { const int i = 4 * i4 + q; const float x = xv[q];
              cnt0 += (x > mine[0] || (x == mine[0] && i < jj)) ? 1 : 0; cnt1 += (x > mine[1] || (x == mine[1] && i < jj + 1)) ? 1 : 0; } }
      if (cnt0 < 16 && valid[0]) bits |= 1u << jj;
      if (cnt1 < 16 && valid[1]) bits |= 1u << (jj + 1);
      bits |= shxu(bits, 1, lane); bits |= shxu(bits, 2, lane); bits |= shxu(bits, 4, lane); bits |= shxu(bits, 8, lane);
      if ((tid & 15) == 0) SEL[(size_t)(b * 4 + g) * SEQ + tq] = bits;
      __syncthreads(); }
}

__device__ __forceinline__ void nsa_sw_unit(int b, int g, int tt, const bf16* Qraw, const float* gq, const float* tabB, const bf16* Ks, const bf16* Vs, const bf16* Kw, const bf16* Vw, const float* gates, const unsigned* SEL, bf16* OB,
                                            LAS unsigned char* lds, int tid, int lane, int wave) {
    const int r32 = lane & 31, h = lane >> 5, t0 = tt * 32, t = t0 + r32, head = g * 8 + wave; const size_t tok = (size_t)b * SEQ + t;
    bf16x8 qf[8]; nsa_load_q<true>(qf, Qraw + tok * 4096 + head * 128, gq, tabB + tok * 64, h, lane);
    const unsigned sel = SEL[(size_t)(b * 4 + g) * SEQ + t]; unsigned uni = sel, all = sel;
#pragma unroll
    for (int o = 1; o < 64; o <<= 1) { uni |= shxu(uni, o, lane); all &= shxu(all, o, lane); }
    all = (unsigned)__builtin_amdgcn_readfirstlane((int)all);
    const int cur = t0 >> 6; const unsigned causal_tiles = cur >= 31 ? 0xffffffffu : ((2u << cur) - 1u);
    const size_t kvoff = (size_t)b * SEQ * 512 + g * 128;
    AttnSt st; attn_init(st);
    attn_pass<128>(st, qf, lds, Ks + kvoff, 512u, Vs + kvoff, 512u, uni & causal_tiles, sel, all, 0, t, 0, t0 + 31, 0, t0, tid, lane);
    { const int l2 = relane(lane); const size_t tok2 = (size_t)b * SEQ + t0 + (l2 & 31);
      attn_out16<true>(st, gates[tok2 * 96 + head * 3 + 1] / st.l, OB + tok2 * DM + head * 128, l2 >> 5); }
    attn_init(st);
    const int wlo = t0 - 511 > 0 ? t0 - 511 : 0, whi = t0 + 31, ktl = wlo >> 6, kth = whi >> 6;
    const unsigned wmask = (kth >= 31 ? 0xffffffffu : ((2u << kth) - 1u)) & ~((1u << ktl) - 1u);
    attn_pass<128>(st, qf, lds, Kw + kvoff, 512u, Vw + kvoff, 512u, wmask, 0xffffffffu, 0xffffffffu, t - 511 > 0 ? t - 511 : 0, t, wlo, whi, (t0 + 31 - 511 > 0 ? t0 + 31 - 511 : 0), t0, tid, lane);
    { const int l2 = relane(lane); const size_t tok2 = (size_t)b * SEQ + t0 + (l2 & 31);
      attn_out16<true>(st, gates[tok2 * 96 + head * 3 + 2] / st.l, OB + tok2 * DM + head * 128, l2 >> 5); }
}
constexpr int N_PHASES = 1 + 2 * 9 + 2 * 8 + 3;
#ifndef MK_MULTI
#define MK_MULTI 0
#endif
__device__ __forceinline__ int lane_id_asm() { int l; asm volatile("v_mbcnt_lo_u32_b32 %0, -1, 0\n\tv_mbcnt_hi_u32_b32 %0, -1, %0" : "=v"(l)); return l; }
__device__ __forceinline__ int opq_v(int v) { asm volatile("" : "+v"(v)); return v; }
__device__ __forceinline__ int opq_s(int v) { asm volatile("" : "+s"(v)); return v; }
#define CAS __attribute__((address_space(4)))
typedef const CAS Args* ArgsP;
__device__ __forceinline__ ArgsP opq_args() { ArgsP p = (ArgsP)__builtin_amdgcn_kernarg_segment_ptr(); asm volatile("" : "+s"(p)); return p; }
__global__ void __launch_bounds__(NTHREADS, 2) trunk_fwd(Args args_k) {
    extern __shared__ __attribute__((aligned(16))) unsigned char lds_raw[];
    LAS unsigned char* lds = (LAS unsigned char*)lds_raw;
    volatile LAS unsigned* MISC = (volatile LAS unsigned*)(lds + MISC_OFF);
    for (int u = threadIdx.x; u < (LDS_BYTES - LDSCTL_OFF) / 4; u += NTHREADS) ((LAS unsigned*)(lds + LDSCTL_OFF))[u] = 0u;
    __syncthreads();
    const int lo = args_k.ph_lo, hi = args_k.ph_hi, wave_k = __builtin_amdgcn_readfirstlane((int)threadIdx.x >> 6);
    XcdBarrier bar; bar.bar = (unsigned*)(args_k.ws + WS_CTL) + CW_BAR; bar.x = 0; bar.st = nullptr;
    if (hi - lo > 1) bar = xcd_barrier_post((unsigned*)(args_k.ws + WS_CTL) + CW_BAR, MISC + 8);
#ifndef MK_PROBE
#define MK_PROBE 0
#endif
#define REP(k) for (int rep_ = 0; rep_ < ((MK_PROBE == (k)) ? 2 : 1); ++rep_)
    int ph = 0, layer_i = 0, sub_i = 0;
#define PH_BEGIN if (ph >= lo && ph < hi) { asm volatile("; PHMARK %0" :: "i"(__LINE__)); const CAS Args& args = *opq_args(); const int layer = opq_s(layer_i), sub = opq_s(sub_i); (void)layer; (void)sub; const int wave = opq_s(wave_k), lane = lane_id_asm(), tid = wave * 64 + lane; \
    const int G = opq_s((int)gridDim.x), bx = opq_s((int)blockIdx.x), vcu = (G % 8 == 0) ? (bx % 8) * (G / 8) + bx / 8 : bx, gw = vcu * NWAVES + wave, NGW = G * NWAVES; (void)lane; (void)gw; (void)NGW; (void)vcu; unsigned char* ws = args.ws; float* ssb = (float*)(ws + SS_OFF); constexpr size_t SSL = (size_t)T * 64; \
    bf16* HB = (bf16*)(ws + WS_HB); bf16* ACT = (bf16*)(ws + WS_ACT); bf16* CBUF = (bf16*)(ws + WS_CBUF); bf16* QRAW = (bf16*)(ws + WS_QRAW); bf16* KVRAW = (bf16*)(ws + WS_KVRAW); \
    bf16* QF = (bf16*)(ws + WS_QF); bf16* KF = (bf16*)(ws + WS_KF); bf16* OB = (bf16*)(ws + WS_OB); float* GATES = (float*)(ws + WS_GATES); unsigned* SEL = (unsigned*)(ws + WS_SEL); \
    float* OACC = (float*)(ws + WS_KVRAW); float* KVS = (float*)(ws + WS_KVS); (void)ssb; (void)HB; (void)ACT; (void)CBUF; (void)QRAW; (void)KVRAW; (void)QF; (void)KF; (void)OB; (void)GATES; (void)SEL; (void)OACC; (void)KVS;
#ifndef MK_BAR2
#define MK_BAR2 0
#endif
#define PH_END if (ph + 1 < hi) { xcd_barrier(bar); if (MK_BAR2) xcd_barrier(bar); } } ++ph;
#define RS_FILL(ssptr, nparts_, invdim_, M_, N_, cidx) pg8::RsTab rt_; { pg8::StaticOrder S0_; S0_.init((M_), (N_), G, (cidx)); pg8::Unit u0_; rt_.tab = (const LAS float*)(lds + RSTAB_OFF); rt_.pm = -1; \
        if (S0_.next(0, u0_)) { rt_.pm = u0_.pm; pg8::rs_table_fill((LAS float*)(lds + RSTAB_OFF), (ssptr), (nparts_), (invdim_), u0_.pm, tid, lane); } }
#define RUN_GEMM(EPI_T, E, Aptr, lda_, Bptr, M_, N_, K_, cidx) do { const pg8::Gemm g_{(const pg8::bf16_t*)(Aptr), (const pg8::bf16_t*)(Bptr), (M_), (N_), (K_), (lda_)}; pg8::StaticOrder S_; S_.init((M_), (N_), G, (cidx)); \
        pg8::gemm_phase<EPI_T, pg8::StaticOrder, EPI_T::ALIGN, true>(lds, g_, S_, (E), opq_v(tid)); } while (0)

    REP(1) {
    PH_BEGIN prologue(args, lds, vcu, G, wave, lane, tid); PH_END
    }

    for (layer_i = 0; layer_i < DEPTH; ++layer_i) {
        for (sub_i = 0; sub_i < 3; ++sub_i) {
            if (sub_i != 1) {
                REP(2) {
                PH_BEGIN { const int which = sub >> 1; unsigned char* wgu = ws + WS_FFN + (size_t)(layer * 2 + which) * FFN_B; const float* ssp = ssb + (size_t)(3 * layer + sub) * SSL; const int np = (layer == 0 && sub == 0) ? 1 : 64; RS_FILL(ssp, np, 1.0f / DM, T, 2 * FF, bx)
                    const pg8::EpiSwiGLU E{ACT, FF, ssp, np, 1.0f / DM, rt_}; RUN_GEMM(pg8::EpiSwiGLU, E, HB, DM, wgu, T, 2 * FF, DM, bx);
                    if (layer == 2 && sub == 0) { nsa_cmp_out(args, lds, gw, NGW, wave, lane); __syncthreads(); }
                    cvt_range(args, 6 * layer + 3 * which + 2, 1, lds, gw, NGW, wave, lane); } PH_END
                }
                PH_BEGIN { const int which = sub >> 1; unsigned char* wgu = ws + WS_FFN + (size_t)(layer * 2 + which) * FFN_B; const bool last = (layer == DEPTH - 1 && sub == 2), first = (layer == 0 && sub == 0);
                    const pg8::EpiResid E{first ? (const float*)args.in[I_X] : nullptr, HB, last ? args.out : nullptr, last ? nullptr : ssb + (size_t)(3 * layer + sub + 1) * SSL, 0.5f, DM}; RUN_GEMM(pg8::EpiResid, E, ACT, FF, wgu + FFN_GU_B, T, DM, FF, bx);
                    if (sub == 0) cvt_range(args, layer < 2 ? 24 + 4 * layer : 32 + 3 * (layer - 2), layer < 2 ? 1 : 2, lds, gw, NGW, wave, lane);
                    else if (layer < DEPTH - 1) { if (layer == 1) cvt_range(args, 38, 4, lds, gw, NGW, wave, lane); else cvt_range(args, 6 * (layer + 1), 2, lds, gw, NGW, wave, lane); } } PH_END
#if MK_PROBE == 7
                PH_BEGIN { const int which = sub >> 1; unsigned char* wgu = ws + WS_FFN + (size_t)(layer * 2 + which) * FFN_B;
                    const pg8::EpiResid E{(const float*)args.in[I_X], (pg8::bf16_t*)(ws + WS_QF), nullptr, nullptr, 0.5f, DM}; RUN_GEMM(pg8::EpiResid, E, ACT, FF, wgu + FFN_GU_B, T, DM, FF, bx); } PH_END
#endif
            } else if (layer_i < 2) {
#define MLA_PTRS unsigned char* wm = ws + WS_MLA + (size_t)layer * MLA_B; float* sscq = ssb + (size_t)(SS_CQ + layer) * SSL; float* ssckv = ssb + (size_t)(SS_CKV + layer) * SSL; (void)wm; (void)sscq; (void)ssckv;
                REP(5) {
                PH_BEGIN { MLA_PTRS RS_FILL(ssb + (size_t)(3 * layer + 1) * SSL, 64, 1.0f / DM, T, MLA_IN_P, bx) const pg8::EpiScaleBf16 E{CBUF, MLA_IN_P, ssb + (size_t)(3 * layer + 1) * SSL, 64, 1.0f / DM, sscq, ssckv, 4, 6, rt_}; RUN_GEMM(pg8::EpiScaleBf16, E, HB, DM, wm, T, MLA_IN_P, DM, bx);
                           constexpr int NU_ = (T / 256) * (MLA_IN_P / 256);
                           if (G > NU_) { if (bx >= NU_) cvt_range(args, 25 + 4 * layer, 2, lds, (bx - NU_) * NWAVES + wave, (G - NU_) * NWAVES, wave, lane); } else cvt_range(args, 25 + 4 * layer, 2, lds, gw, NGW, wave, lane); } PH_END
                PH_BEGIN { MLA_PTRS { RS_FILL(sscq, 16, 1.0f / QLORA, T, 6144, bx) const pg8::EpiScaleBf16 E1{QRAW, 6144, sscq, 16, 1.0f / QLORA, nullptr, nullptr, 0, 0, rt_}; RUN_GEMM(pg8::EpiScaleBf16, E1, CBUF, MLA_IN_P, wm + MLA_WIN_B, T, 6144, QLORA, bx); }
                           RS_FILL(ssckv, 8, 1.0f / KVLORA, T, 8192, bx) const pg8::EpiScaleBf16 E2{KVRAW, 8192, ssckv, 8, 1.0f / KVLORA, nullptr, nullptr, 0, 0, rt_}; RUN_GEMM(pg8::EpiScaleBf16, E2, CBUF + QLORA, MLA_IN_P, wm + MLA_WIN_B + MLA_WUQ_B, T, 8192, KVLORA, bx); } PH_END
                }
                REP(3) {
                PH_BEGIN mla_k_finalize(KVRAW, CBUF, (const float*)args.in[I_MGK] + layer * MLA_QK, (const float*)(ws + WS_TABA), KF, gw, NGW, lane); PH_END
                PH_BEGIN for (int u = vcu; u < 512; u += G) { const int bh = u >> 2, pi = u & 3;
                             const float* gq = (const float*)args.in[I_MGQ] + layer * MLA_QK; const float* tabA = (const float*)(ws + WS_TABA);
                             mla_attn_unit(bh >> 5, bh & 31, 7 - pi, QRAW, gq, tabA, KF, KVRAW, OB, lds, tid, lane, wave); mla_attn_unit(bh >> 5, bh & 31, pi, QRAW, gq, tabA, KF, KVRAW, OB, lds, tid, lane, wave); }
                         __syncthreads(); cvt_range(args, 27 + 4 * layer, 1, lds, gw, NGW, wave, lane); PH_END
                }
                PH_BEGIN { MLA_PTRS const pg8::EpiResid E{nullptr, HB, nullptr, ssb + (size_t)(3 * layer + 2) * SSL, 1.0f, DM}; RUN_GEMM(pg8::EpiResid, E, OB, DM, wm + MLA_WIN_B + MLA_WUQ_B + MLA_WUKV_B, T, DM, DM, bx); cvt_range(args, 6 * layer + 3, 2, lds, gw, NGW, wave, lane); } PH_END
#if MK_PROBE == 9
                PH_BEGIN { MLA_PTRS const pg8::EpiResid E{(const float*)args.in[I_X], (pg8::bf16_t*)(ws + WS_QF), nullptr, nullptr, 1.0f, DM}; RUN_GEMM(pg8::EpiResid, E, OB, DM, wm + MLA_WIN_B + MLA_WUQ_B + MLA_WUKV_B, T, DM, DM, bx); } PH_END
#endif
            } else {
#define NSA_PTRS const int bl = layer - 2; unsigned char* wn = ws + WS_NSA + (size_t)bl * NSA_B;
                REP(8) PH_BEGIN { NSA_PTRS const float* ssm = ssb + (size_t)(3 * layer + 1) * SSL;
                    { RS_FILL(ssm, 64, 1.0f / DM, T, 4096, bx) const pg8::EpiScaleBf16 E{QRAW, 4096, ssm, 64, 1.0f / DM, nullptr, nullptr, 0, 0, rt_}; RUN_GEMM(pg8::EpiScaleBf16, E, HB, DM, wn, T, 4096, DM, bx); }
                    for (int uid = bx; uid < 256; uid += G) { const int ks = uid >> 5, c2 = uid & 31; RS_FILL(ssm, 64, 1.0f / DM, T, 256, c2)
                        const pg8::EpiGateP E2{(float*)(ws + WS_GP) + (size_t)ks * T * 96, ssm, 64, 1.0f / DM, rt_};
                        const pg8::Gemm g2{(const pg8::bf16_t*)(HB + ks * 512), (const pg8::bf16_t*)(wn + NSA_WQ_B + (size_t)ks * GSL_B), T, 256, 512, DM}; pg8::StaticOrder S2; S2.init(T, 256, 32, c2);
                        pg8::gemm_phase<pg8::EpiGateP, pg8::StaticOrder, true, true>(lds, g2, S2, E2, opq_v(tid)); } } PH_END
                REP(4) {
                PH_BEGIN for (int u = vcu; u < 512; u += G) { const int bg = u >> 5, pi = u & 31;
                             nsa_cmp_unit(bg >> 2, bg & 3, 63 - pi, QRAW, (const float*)args.in[I_NGQ] + (layer - 2) * DH, (const bf16*)(ws + WS_KC), (const bf16*)(ws + WS_VC), (const float*)(ws + WS_GP), (const float*)args.in[I_NBG] + (layer - 2) * 96, GATES, OB, SEL, lds, tid, lane, wave);
                             nsa_cmp_unit(bg >> 2, bg & 3, pi, QRAW, (const float*)args.in[I_NGQ] + (layer - 2) * DH, (const bf16*)(ws + WS_KC), (const bf16*)(ws + WS_VC), (const float*)(ws + WS_GP), (const float*)args.in[I_NBG] + (layer - 2) * 96, GATES, OB, SEL, lds, tid, lane, wave); } PH_END
                PH_BEGIN for (int u = vcu; u < 512; u += G) { const int bg = u >> 5, pi = u & 31;
                             nsa_sw_unit(bg >> 2, bg & 3, 63 - pi, QRAW, (const float*)args.in[I_NGQ] + (layer - 2) * DH, (const float*)(ws + WS_TABB), (const bf16*)(ws + WS_KSLC), (const bf16*)(ws + WS_VSLC), (const bf16*)(ws + WS_KWIN), (const bf16*)(ws + WS_VWIN), GATES, SEL, OB, lds, tid, lane, wave);
                             nsa_sw_unit(bg >> 2, bg & 3, pi, QRAW, (const float*)args.in[I_NGQ] + (layer - 2) * DH, (const float*)(ws + WS_TABB), (const bf16*)(ws + WS_KSLC), (const bf16*)(ws + WS_VSLC), (const bf16*)(ws + WS_KWIN), (const bf16*)(ws + WS_VWIN), GATES, SEL, OB, lds, tid, lane, wave); }
                         __syncthreads(); cvt_range(args, 34 + 3 * (layer - 2), 1, lds, gw, NGW, wave, lane); PH_END
                }
                PH_BEGIN { NSA_PTRS const pg8::EpiResid E{nullptr, HB, nullptr, ssb + (size_t)(3 * layer + 2) * SSL, 1.0f, DM}; RUN_GEMM(pg8::EpiResid, E, OB, DM, wn + NSA_WIN_B, T, DM, DM, bx); cvt_range(args, 6 * layer + 3, 2, lds, gw, NGW, wave, lane); } PH_END
#if MK_PROBE == 9
                PH_BEGIN { NSA_PTRS const pg8::EpiResid E{(const float*)args.in[I_X], (pg8::bf16_t*)(ws + WS_QF), nullptr, nullptr, 1.0f, DM}; RUN_GEMM(pg8::EpiResid, E, OB, DM, wn + NSA_WIN_B, T, DM, DM, bx); } PH_END
#endif
            }
        }
        if (layer_i == 1) {
            REP(6) {
            PH_BEGIN { const float* ss6 = ssb + (size_t)6 * SSL;
                { RS_FILL(ss6, 64, 1.0f / DM, T, 2048, bx) const pg8::EpiScaleF32 E{KVS, NKV, ss6, 64, 1.0f / DM, rt_}; RUN_GEMM(pg8::EpiScaleF32, E, HB, DM, ws + WS_KVW, T, 2048, DM, bx); }
                for (int uid = bx; uid < 256; uid += G) { const int ks = uid >> 7, c2 = uid & 127; RS_FILL(ss6, 64, 1.0f / DM, T, 1024, c2)
                    const pg8::EpiScaleF32 E2{(float*)(ws + WS_ACT) + (size_t)ks * T * 1024, 1024, ss6, 64, 1.0f / DM, rt_};
                    const pg8::Gemm g2{(const pg8::bf16_t*)(HB + ks * 2048), (const pg8::bf16_t*)(ws + WS_KVW + (size_t)2048 * DM * 2) + (size_t)ks * 1024 * 2048, T, 1024, 2048, DM}; pg8::StaticOrder S2; S2.init(T, 1024, 128, c2);
                    pg8::gemm_phase<pg8::EpiScaleF32, pg8::StaticOrder, true, true>(lds, g2, S2, E2, opq_v(tid)); } } PH_END
            PH_BEGIN nsa_kv_finalize(args, gw, NGW, lane); PH_END
            PH_BEGIN {
                for (int uid = bx; uid < 128; uid += G) { const int mat = uid >> 6, ks = (uid >> 3) & 7, c2 = uid & 7;
                    const pg8::EpiPartF32 E{(float*)(ws + WS_KVS) + (size_t)(mat * 8 + ks) * CMP_ROWS_P * 256, 256};
                    const pg8::Gemm g2{(const pg8::bf16_t*)(ws + (mat ? WS_BLKV : WS_BLKK)) + ks * 512, (const pg8::bf16_t*)(ws + WS_CW1 + (size_t)mat * CW1_B + (size_t)ks * GSL_B), CMP_ROWS_P, 256, 512, 4096};
                    pg8::StaticOrder S2; S2.init(CMP_ROWS_P, 256, 8, c2); pg8::gemm_phase<pg8::EpiPartF32, pg8::StaticOrder, true, true>(lds, g2, S2, E, opq_v(tid)); }
                cvt_range(args, 12, 2, lds, gw, NGW, wave, lane); } PH_END
            }
        }
    }
#undef PH_BEGIN
#undef PH_END
#undef RUN_GEMM
}

extern "C" void kernel_launch(void* const* d_in, const int* in_sizes, int n_in, void* d_out, int out_size, void* d_ws, size_t ws_size, hipStream_t stream) {
    static int grid = 0;
    if (grid == 0) {
        if (n_in != 36 || in_sizes[0] != T * DM || out_size != T * DM || ws_size < WS_END) { fprintf(stderr, "kernel_launch: unexpected problem (n_in %d, in0 %d, out %d, ws %zu < %zu); nothing launched\n", n_in, n_in > 0 ? in_sizes[0] : -1, out_size, ws_size, (size_t)WS_END); grid = -1; return; }
        int dev = 0, cus = 0, per_cu = 0;
        if (hipGetDevice(&dev) != hipSuccess || hipDeviceGetAttribute(&cus, hipDeviceAttributeMultiprocessorCount, dev) != hipSuccess) { fprintf(stderr, "kernel_launch: device query failed\n"); grid = -1; return; }
        if (hipFuncSetAttribute((const void*)trunk_fwd, hipFuncAttributeMaxDynamicSharedMemorySize, LDS_BYTES) != hipSuccess) { fprintf(stderr, "kernel_launch: hipFuncSetAttribute failed\n"); grid = -1; return; }
        if (hipOccupancyMaxActiveBlocksPerMultiprocessor(&per_cu, (const void*)trunk_fwd, NTHREADS, LDS_BYTES) != hipSuccess || per_cu < 1) { fprintf(stderr, "kernel_launch: occupancy query reports %d workgroups per CU; nothing launched\n", per_cu); (void)hipGetLastError(); grid = -1; return; }
        grid = cus;
    }
    if (grid < 0) return;
    if (hipMemsetAsync((char*)d_ws + WS_CTL, 0, CTL_ZERO_BYTES, stream) != hipSuccess) { fprintf(stderr, "kernel_launch: hipMemsetAsync failed\n"); return; }
    Args a{};
    for (int i = 0; i < 36; ++i) a.in[i] = d_in[i];
    a.out = (float*)d_out; a.ws = (unsigned char*)d_ws;
#if MK_MULTI
    for (int p = 0; p < N_PHASES; ++p) { a.ph_lo = p; a.ph_hi = p + 1; hipLaunchKernelGGL(trunk_fwd, dim3(grid), dim3(NTHREADS), LDS_BYTES, stream, a); }
#else
    a.ph_lo = 0; a.ph_hi = MK_PROBE ? 1000 : N_PHASES; hipLaunchKernelGGL(trunk_fwd, dim3(grid), dim3(NTHREADS), LDS_BYTES, stream, a);
#endif
    const hipError_t le = hipPeekAtLastError();
    if (le != hipSuccess) fprintf(stderr, "kernel_launch: launch failed: %s\n", hipGetErrorName(le));
}
```

```cpp
#include <hip/hip_runtime.h>
#include <cstdio>
#include <cstdint>
namespace pg8 {
#define PG8_LAS __attribute__((address_space(3)))
typedef unsigned short bf16_t;
typedef short bf16x8 __attribute__((ext_vector_type(8)));
typedef float f32x4 __attribute__((ext_vector_type(4)));
typedef unsigned u32x4 __attribute__((ext_vector_type(4)));
constexpr int BM = 256, BK = 64, HALF = 128, HTB = HALF * BK * 2  , STAGE_BYTES = 8 * HTB, NXCD = 8, WGM = 8;

__host__ __device__ __forceinline__ int lds_byte(int r, int c) { const int st = (r >> 4) * 2 + (c >> 5), rr = r & 15, cc = c & 31, ob = rr * 64 + cc * 2; return st * 1024 + (ob ^ (((ob >> 9) & 1) << 5)); }
__host__ __device__ __forceinline__ void stage_rc(int b, int& R, int& C) { const int st = b / 1024, sb = b % 1024, swz = sb ^ (((sb >> 9) & 1) << 5); R = (st >> 1) * 16 + swz / 64; C = (st & 1) * 32 + (swz % 64) / 2; }
__host__ __device__ __forceinline__ int perm32(int rho) { const int n = rho >> 4, i = rho & 15; return 8 * (i >> 2) + 4 * n + (i & 3); }

struct Unit { int pm, pn; };
struct Gemm { const bf16_t* A; const bf16_t* Bt; int M, N, K, lda; };

struct StaticOrder {
    int nM, nN, nwg, G, c;
    __host__ __device__ __forceinline__ void init(int M, int N, int G_, int c_) { nM = M / BM; nN = N / BM; nwg = nM * nN; G = G_; c = c_; }
    __host__ __device__ __forceinline__ bool next(int i, Unit& u) const {
        const long L = (long)i * G + c; if (L >= nwg) return false;
        int wgid = (int)L; { const int q = nwg / NXCD, r = nwg % NXCD, xcd = wgid % NXCD, off = wgid / NXCD; wgid = (xcd < r ? xcd * (q + 1) : r * (q + 1) + (xcd - r) * q) + off; }
        const int nig = WGM * nN, gid = wgid / nig, fm = gid * WGM, gsz = (nM - fm) < WGM ? (nM - fm) : WGM;
        u.pm = fm + ((wgid % nig) % gsz); u.pn = (wgid % nig) / gsz; return true;
    }
    __device__ __forceinline__ void a_ready(const Unit&) const {}
    __device__ __forceinline__ void done(const Unit&) const {}
};

__device__ __forceinline__ unsigned cvt_pk_bf16(float lo, float hi) { unsigned r; asm volatile("s_nop 0\n\tv_cvt_pk_bf16_f32 %0, %1, %2\n\ts_nop 1" : "=v"(r) : "v"(lo), "v"(hi)); return r; }
constexpr float RMS_EPS = 1e-6f;
__device__ __forceinline__ float silu_f(float g) { return g * __builtin_amdgcn_rcpf(1.0f + __builtin_amdgcn_exp2f(-1.4426950408889634f * g)); }
__device__ __forceinline__ float sigmoid_f(float g) { return __builtin_amdgcn_rcpf(1.0f + __builtin_amdgcn_exp2f(-1.4426950408889634f * g)); }
__device__ __forceinline__ float shx(float v, int mask, int lane) { return __builtin_bit_cast(float, __builtin_amdgcn_ds_bpermute((lane ^ mask) << 2, __builtin_bit_cast(int, v))); }
__device__ __forceinline__ unsigned shxu(unsigned v, int mask, int lane) { return (unsigned)__builtin_amdgcn_ds_bpermute((lane ^ mask) << 2, (int)v); }
__device__ __forceinline__ float quad_sq(const f32x4 v) { return (v[0] * v[0] + v[1] * v[1]) + (v[2] * v[2] + v[3] * v[3]); }

__device__ __forceinline__ float row_rstd(const float* P, int row, int nparts, float inv_dim, int fq, int lane) {
    float s = 0.f; const float* p = P + (size_t)row * 64;
    if (nparts >= 16) { const int q = nparts >> 2; p += fq * q;
        for (int i = 0; i < q; i += 4) { const f32x4 v = *(const f32x4*)(p + i); s += (v[0] + v[1]) + (v[2] + v[3]); }
        s += shx(s, 16, lane); s += shx(s, 32, lane);
    } else { for (int i = 0; i < nparts; ++i) s += p[i]; }
    return __builtin_amdgcn_rsqf(s * inv_dim + RMS_EPS);
}
struct RsTab { const PG8_LAS float* tab; int pm; };
__device__ __forceinline__ float rs_lookup(const RsTab& t, const Unit& u, int lrow, const float* P, int row, int nparts, float inv_dim, int fq, int lane) {
    return (u.pm == t.pm) ? t.tab[lrow] : row_rstd(P, row, nparts, inv_dim, fq, lane);
}
__device__ __forceinline__ void rs_table_fill(PG8_LAS float* tab, const float* P, int nparts, float inv_dim, int pm, int tid, int lane) {
    const int r = tid >> 1, half = tid & 1; const float* p = P + ((size_t)pm * 256 + r) * 64; float s = 0.f;
    if (nparts >= 8) { const int per = nparts >> 1; p += half * per; for (int i = 0; i < per; i += 4) { const f32x4 v = *(const f32x4*)(p + i); s += (v[0] + v[1]) + (v[2] + v[3]); } }
    else if (half == 0) { for (int i = 0; i < nparts; ++i) s += p[i]; }
    s += shx(s, 1, lane);
    if (half == 0) tab[r] = __builtin_amdgcn_rsqf(s * inv_dim + RMS_EPS);
    __syncthreads();
}
struct EpiSwiGLU {
    static constexpr bool PERM = true, AFTER_DRAIN = false, ALIGN = true;
    bf16_t* O; int ldc; const float* ss; int nparts; float inv_dim; RsTab rt;
    __device__ __forceinline__ void operator()(const f32x4 (&acc)[2][2][4][2], const Unit& u, int wr, int wc, int fr, int fq) const {
        const int row0 = u.pm * BM + wr * 64 + fr, col0 = u.pn * HALF + wc * 32 + 8 * fq;
#ifndef MK_EPI2
#define MK_EPI2 1
#endif
#pragma nounroll
        for (int rep_ = 0; rep_ < MK_EPI2; ++rep_) { asm volatile("" ::: "memory");
#pragma unroll
        for (int ai = 0; ai < 2; ++ai)
#pragma unroll
            for (int m = 0; m < 4; ++m) { const int row = row0 + ai * HALF + m * 16; const float rs = rs_lookup(rt, u, row - u.pm * BM, ss, row, nparts, inv_dim, fq, fq * 16 + fr);
                typedef float f32x2e __attribute__((ext_vector_type(2)));
                float o[8]; const float nr = -1.4426950408889634f * rs, r2 = rs * rs; const f32x2e nr2 = {nr, nr}, rs2 = {r2, r2}, one2 = {1.0f, 1.0f};
#pragma unroll
                for (int n = 0; n < 2; ++n)
#pragma unroll
                    for (int jp = 0; jp < 2; ++jp) { const f32x2e g2 = {acc[ai][0][m][n][2 * jp], acc[ai][0][m][n][2 * jp + 1]}, u2 = {acc[ai][1][m][n][2 * jp], acc[ai][1][m][n][2 * jp + 1]};
                        const f32x2e t2 = g2 * nr2; const f32x2e d2 = (f32x2e){__builtin_amdgcn_exp2f(t2.x), __builtin_amdgcn_exp2f(t2.y)} + one2;
                        const f32x2e q2 = (g2 * u2) * rs2 * (f32x2e){__builtin_amdgcn_rcpf(d2.x), __builtin_amdgcn_rcpf(d2.y)};
                        o[4 * n + 2 * jp] = q2.x; o[4 * n + 2 * jp + 1] = q2.y; }
                u32x4 w; w.x = cvt_pk_bf16(o[0], o[1]); w.y = cvt_pk_bf16(o[2], o[3]); w.z = cvt_pk_bf16(o[4], o[5]); w.w = cvt_pk_bf16(o[6], o[7]);
                *(u32x4*)(O + (size_t)row * ldc + col0) = w; }
        }
    }
};
struct EpiResid {
    static constexpr bool PERM = true, AFTER_DRAIN = false, ALIGN = true;
    const float* xin; bf16_t* hb; float* fout; float* ssout; float scale; int ldc;
    __device__ __forceinline__ static f32x4 lo4(const u32x4 w) { return (f32x4){__builtin_bit_cast(float, w.x << 16), __builtin_bit_cast(float, w.x & 0xffff0000u), __builtin_bit_cast(float, w.y << 16), __builtin_bit_cast(float, w.y & 0xffff0000u)}; }
    __device__ __forceinline__ static f32x4 hi4(const u32x4 w) { return (f32x4){__builtin_bit_cast(float, w.z << 16), __builtin_bit_cast(float, w.z & 0xffff0000u), __builtin_bit_cast(float, w.w << 16), __builtin_bit_cast(float, w.w & 0xffff0000u)}; }
    __device__ __forceinline__ void finish(const f32x4 v0, const f32x4 v1, size_t o2, float& sq) const {
        sq += quad_sq(v0) + quad_sq(v1);
        if (fout) { __builtin_nontemporal_store(v0, (f32x4*)(fout + o2)); __builtin_nontemporal_store(v1, (f32x4*)(fout + o2 + 4)); }
        else { u32x4 w; w.x = cvt_pk_bf16(v0[0], v0[1]); w.y = cvt_pk_bf16(v0[2], v0[3]); w.z = cvt_pk_bf16(v1[0], v1[1]); w.w = cvt_pk_bf16(v1[2], v1[3]); *(u32x4*)(hb + o2) = w; } }
    __device__ __forceinline__ void operator()(const f32x4 (&acc)[2][2][4][2], const Unit& u, int wr, int wc, int fr, int fq) const {
        const int row0 = u.pm * BM + wr * 64 + fr, col0 = u.pn * BM + wc * 32 + 8 * fq;
#pragma unroll
        for (int ai = 0; ai < 2; ++ai) {
            if (xin) {
#pragma unroll
                for (int mp = 0; mp < 2; ++mp) { f32x4 hv[2][2][2];
#pragma unroll
                    for (int mm = 0; mm < 2; ++mm)
#pragma unroll
                        for (int bj = 0; bj < 2; ++bj) { const size_t o2 = (size_t)(row0 + ai * HALF + (2 * mp + mm) * 16) * ldc + col0 + bj * HALF; hv[mm][bj][0] = __builtin_nontemporal_load((const f32x4*)(xin + o2)); hv[mm][bj][1] = __builtin_nontemporal_load((const f32x4*)(xin + o2 + 4)); }
#pragma unroll
                    for (int mm = 0; mm < 2; ++mm) { const int m = 2 * mp + mm, row = row0 + ai * HALF + m * 16; float sq = 0.f;
#pragma unroll
                        for (int bj = 0; bj < 2; ++bj) finish(hv[mm][bj][0] + acc[ai][bj][m][0] * scale, hv[mm][bj][1] + acc[ai][bj][m][1] * scale, (size_t)row * ldc + col0 + bj * HALF, sq);
                        if (ssout) { sq += shx(sq, 16, fq * 16 + fr); sq += shx(sq, 32, fq * 16 + fr); if (fq == 0) ssout[(size_t)row * 64 + u.pn * 4 + wc] = sq; } }
                    asm volatile("" ::: "memory"); }
            } else {
                u32x4 raw[4][2];
#pragma unroll
                for (int m = 0; m < 4; ++m)
#pragma unroll
                    for (int bj = 0; bj < 2; ++bj) raw[m][bj] = *(const u32x4*)(hb + (size_t)(row0 + ai * HALF + m * 16) * ldc + col0 + bj * HALF);
#pragma unroll
                for (int m = 0; m < 4; ++m) { const int row = row0 + ai * HALF + m * 16; float sq = 0.f;
#pragma unroll
                    for (int bj = 0; bj < 2; ++bj) finish(lo4(raw[m][bj]) + acc[ai][bj][m][0] * scale, hi4(raw[m][bj]) + acc[ai][bj][m][1] * scale, (size_t)row * ldc + col0 + bj * HALF, sq);
                    if (ssout) { sq += shx(sq, 16, fq * 16 + fr); sq += shx(sq, 32, fq * 16 + fr); if (fq == 0) ssout[(size_t)row * 64 + u.pn * 4 + wc] = sq; } }
                asm volatile("" ::: "memory"); }
        }
    }
};
struct EpiScaleBf16 {
    static constexpr bool PERM = true, AFTER_DRAIN = false, ALIGN = true;
    bf16_t* O; int ldc; const float* ss; int nparts; float inv_dim; float* ssA; float* ssB; int t0, t1; RsTab rt;
    __device__ __forceinline__ void operator()(const f32x4 (&acc)[2][2][4][2], const Unit& u, int wr, int wc, int fr, int fq) const {
        const int row0 = u.pm * BM + wr * 64 + fr, col0 = u.pn * BM + wc * 32 + 8 * fq;
        float* sso = (u.pn < t0) ? ssA : ((u.pn < t1) ? ssB : nullptr);
#pragma unroll
        for (int ai = 0; ai < 2; ++ai)
#pragma unroll
            for (int m = 0; m < 4; ++m) { const int row = row0 + ai * HALF + m * 16; const float rs = rs_lookup(rt, u, row - u.pm * BM, ss, row, nparts, inv_dim, fq, fq * 16 + fr); float sq = 0.f;
#pragma unroll
                for (int bj = 0; bj < 2; ++bj) { const f32x4 v0 = acc[ai][bj][m][0] * rs, v1 = acc[ai][bj][m][1] * rs; sq += quad_sq(v0) + quad_sq(v1);
                    u32x4 w; w.x = cvt_pk_bf16(v0[0], v0[1]); w.y = cvt_pk_bf16(v0[2], v0[3]); w.z = cvt_pk_bf16(v1[0], v1[1]); w.w = cvt_pk_bf16(v1[2], v1[3]);
                    *(u32x4*)(O + (size_t)row * ldc + col0 + bj * HALF) = w; }
                if (sso) { sq += shx(sq, 16, fq * 16 + fr); sq += shx(sq, 32, fq * 16 + fr); if (fq == 0) sso[(size_t)row * 64 + (u.pn < t0 ? u.pn : u.pn - t0) * 4 + wc] = sq; } }
    }
};
struct EpiScaleF32 {
    static constexpr bool PERM = false, AFTER_DRAIN = false, ALIGN = true;
    float* C; int ldc; const float* ss; int nparts; float inv_dim; RsTab rt;
    __device__ __forceinline__ void operator()(const f32x4 (&acc)[2][2][4][2], const Unit& u, int wr, int wc, int fr, int fq) const {
        const int row0 = u.pm * BM + wr * 64 + fr, col0 = u.pn * BM + wc * 32 + 4 * fq;
#pragma unroll
        for (int ai = 0; ai < 2; ++ai)
#pragma unroll
            for (int m = 0; m < 4; ++m) { const int row = row0 + ai * HALF + m * 16; const float rs = rs_lookup(rt, u, row - u.pm * BM, ss, row, nparts, inv_dim, fq, fq * 16 + fr); float* rowp = C + (size_t)row * ldc + col0;
#pragma unroll
                for (int bj = 0; bj < 2; ++bj)
#pragma unroll
                    for (int n = 0; n < 2; ++n) *(f32x4*)(rowp + bj * HALF + n * 16) = acc[ai][bj][m][n] * rs; }
    }
};
struct EpiNsaIn {
    static constexpr bool PERM = true, AFTER_DRAIN = false, ALIGN = true;
    bf16_t* Q; float* gates; const float* bgate; const float* ss; int nparts; float inv_dim; RsTab rt;
    __device__ __forceinline__ void operator()(const f32x4 (&acc)[2][2][4][2], const Unit& u, int wr, int wc, int fr, int fq) const {
        const int row0 = u.pm * BM + wr * 64 + fr, lc0 = wc * 32 + 8 * fq;
#pragma unroll
        for (int ai = 0; ai < 2; ++ai)
#pragma unroll
            for (int m = 0; m < 4; ++m) { const int row = row0 + ai * HALF + m * 16; const float rs = rs_lookup(rt, u, row - u.pm * BM, ss, row, nparts, inv_dim, fq, fq * 16 + fr);
                if (u.pn < 16) {
#pragma unroll
                    for (int bj = 0; bj < 2; ++bj) { const f32x4 v0 = acc[ai][bj][m][0] * rs, v1 = acc[ai][bj][m][1] * rs;
                        u32x4 w; w.x = cvt_pk_bf16(v0[0], v0[1]); w.y = cvt_pk_bf16(v0[2], v0[3]); w.z = cvt_pk_bf16(v1[0], v1[1]); w.w = cvt_pk_bf16(v1[2], v1[3]);
                        *(u32x4*)(Q + (size_t)row * 4096 + u.pn * BM + lc0 + bj * HALF) = w; }
                } else if (lc0 < 96) {
#pragma unroll
                    for (int n = 0; n < 2; ++n) { const f32x4 b = *(const f32x4*)(bgate + lc0 + 4 * n); f32x4 v = acc[ai][0][m][n] * rs + b;
                        v[0] = sigmoid_f(v[0]); v[1] = sigmoid_f(v[1]); v[2] = sigmoid_f(v[2]); v[3] = sigmoid_f(v[3]);
                        *(f32x4*)(gates + (size_t)row * 96 + lc0 + 4 * n) = v; }
                } }
    }
};
struct EpiGateP {
    static constexpr bool PERM = true, AFTER_DRAIN = false, ALIGN = true;
    float* P; const float* ss; int nparts; float inv_dim; RsTab rt;
    __device__ __forceinline__ void operator()(const f32x4 (&acc)[2][2][4][2], const Unit& u, int wr, int wc, int fr, int fq) const {
        const int row0 = u.pm * BM + wr * 64 + fr, lc0 = wc * 32 + 8 * fq;
#pragma unroll
        for (int ai = 0; ai < 2; ++ai)
#pragma unroll
            for (int m = 0; m < 4; ++m) { const int row = row0 + ai * HALF + m * 16; const float rs = rs_lookup(rt, u, row - u.pm * BM, ss, row, nparts, inv_dim, fq, fq * 16 + fr);
                if (lc0 < 96) {
#pragma unroll
                    for (int n = 0; n < 2; ++n) *(f32x4*)(P + (size_t)row * 96 + lc0 + 4 * n) = acc[ai][0][m][n] * rs; } }
    }
};
struct EpiPartF32 {
    static constexpr bool PERM = false, AFTER_DRAIN = false, ALIGN = true;
    float* C; int ldc;
    __device__ __forceinline__ void operator()(const f32x4 (&acc)[2][2][4][2], const Unit& u, int wr, int wc, int fr, int fq) const {
        const int row0 = u.pm * BM + wr * 64 + fr, col0 = u.pn * BM + wc * 32 + 4 * fq;
#pragma unroll
        for (int ai = 0; ai < 2; ++ai)
#pragma unroll
            for (int m = 0; m < 4; ++m) { float* rowp = C + (size_t)(row0 + ai * HALF + m * 16) * ldc + col0;
#pragma unroll
                for (int bj = 0; bj < 2; ++bj)
#pragma unroll
                    for (int n = 0; n < 2; ++n) *(f32x4*)(rowp + bj * HALF + n * 16) = acc[ai][bj][m][n]; }
    }
};
struct EpiCmpHidden {
    static constexpr bool PERM = true, AFTER_DRAIN = false, ALIGN = true;
    bf16_t* O; const float* b1;
    __device__ __forceinline__ void operator()(const f32x4 (&acc)[2][2][4][2], const Unit& u, int wr, int wc, int fr, int fq) const {
        const int row0 = u.pm * BM + wr * 64 + fr, col0 = wc * 32 + 8 * fq;
#pragma unroll
        for (int ai = 0; ai < 2; ++ai)
#pragma unroll
            for (int m = 0; m < 4; ++m) { const int row = row0 + ai * HALF + m * 16;
#pragma unroll
                for (int bj = 0; bj < 2; ++bj) { const f32x4 b0 = *(const f32x4*)(b1 + col0 + bj * HALF), bb1 = *(const f32x4*)(b1 + col0 + bj * HALF + 4);
                    const f32x4 v0 = acc[ai][bj][m][0] + b0, v1 = acc[ai][bj][m][1] + bb1;
                    u32x4 w; w.x = cvt_pk_bf16(silu_f(v0[0]), silu_f(v0[1])); w.y = cvt_pk_bf16(silu_f(v0[2]), silu_f(v0[3])); w.z = cvt_pk_bf16(silu_f(v1[0]), silu_f(v1[1])); w.w = cvt_pk_bf16(silu_f(v1[2]), silu_f(v1[3]));
                    *(u32x4*)(O + (size_t)row * 256 + col0 + bj * HALF) = w; } }
    }
};

template <class Epi, class Sched, bool ALIGN_EPI = false, bool SP2 = false>
__device__ __forceinline__ void gemm_phase(PG8_LAS unsigned char* lds, const Gemm g, const Sched& S, const Epi& E, const int tid) {
    const int wid = __builtin_amdgcn_readfirstlane(tid >> 6), lane = tid & 63, wr = wid >> 2, wc = wid & 3, fr = lane & 15, fq = lane >> 4;
    const int K = g.K, nt = K / BK;
    unsigned voffA[2], voffB[2];
#pragma unroll
    for (int i = 0; i < 2; ++i) { int R, C; stage_rc(tid * 16 + i * 8192, R, C); const int Rb = Epi::PERM ? ((R & ~31) + perm32(R & 31)) : R;
        voffA[i] = (unsigned)(R * g.lda + C) * 2u; voffB[i] = (unsigned)(Rb * K + C) * 2u; }
    const size_t kstep = (size_t)(BK * 2);
    const size_t hstepA = (size_t)HALF * g.lda * 2, hstepB = (size_t)HALF * K * 2;
    const size_t tstepA = 2 * hstepA, tstepB = 2 * hstepB;
    const unsigned ldsw = (unsigned)wid * 1024u;
    const int aoff = lds_byte(wr * 64 + fr, fq * 8), boff = lds_byte(wc * 32 + fr, fq * 8);
#define PG8_SA(b, h) (((b) * 2 + (h)) * HTB)
#define PG8_SB(b, h) ((4 + (b) * 2 + (h)) * HTB)
#define PG8_STAGE(bufoff, gbase, voff) do { _Pragma("unroll") for (int _i = 0; _i < 2; ++_i) \
        __builtin_amdgcn_global_load_lds((const unsigned*)((const char*)(gbase) + (voff)[_i]), (PG8_LAS unsigned*)(lds + (bufoff) + ldsw + _i * 8192), 16, 0, 0); } while (0)
#define PG8_LDA(dst, b, h) do { _Pragma("unroll") for (int m = 0; m < 4; ++m) _Pragma("unroll") for (int k = 0; k < 2; ++k) dst[m][k] = *(const PG8_LAS bf16x8*)(lds + PG8_SA(b, h) + aoff + m * 2048 + k * 1024); } while (0)
#define PG8_LDB(dst, b, h) do { _Pragma("unroll") for (int n = 0; n < 2; ++n) _Pragma("unroll") for (int k = 0; k < 2; ++k) dst[n][k] = *(const PG8_LAS bf16x8*)(lds + PG8_SB(b, h) + boff + n * 2048 + k * 1024); } while (0)
#define PG8_MMA(ai, bj, At, Bt) do { __builtin_amdgcn_s_setprio(1); _Pragma("unroll") for (int m = 0; m < 4; ++m) _Pragma("unroll") for (int n = 0; n < 2; ++n) _Pragma("unroll") for (int k = 0; k < 2; ++k) \
        acc[ai][bj][m][n] = __builtin_amdgcn_mfma_f32_16x16x32_bf16(Bt[n][k], At[m][k], acc[ai][bj][m][n], 0, 0, 0); __builtin_amdgcn_s_setprio(0); } while (0)
#define PG8_WAIT_V(n) asm volatile("s_waitcnt vmcnt(" #n ")" ::: "memory")
#define PG8_WAIT_L(n) asm volatile("s_waitcnt lgkmcnt(" #n ")" ::: "memory")
#define PG8_BAR __builtin_amdgcn_s_barrier()
#define PG8_SCHED __builtin_amdgcn_sched_barrier(0)
    Unit cur, nxt; int ui = 0;
    if (!S.next(0, cur)) return;
    f32x4 acc[2][2][4][2];
#pragma unroll
    for (int a = 0; a < 2; ++a)
#pragma unroll
        for (int b = 0; b < 2; ++b)
#pragma unroll
            for (int m = 0; m < 4; ++m)
#pragma unroll
                for (int n = 0; n < 2; ++n) acc[a][b][m][n] = (f32x4){0.f, 0.f, 0.f, 0.f};
    bf16x8 At[4][2], B0[2][2], B1[2][2];
    const char* cA = (const char*)g.A + (size_t)cur.pm * tstepA; const char* cB = (const char*)g.Bt + (size_t)cur.pn * tstepB;
    S.a_ready(cur);
    if constexpr (SP2) {
        PG8_STAGE(PG8_SB(0, 0), cB, voffB); PG8_STAGE(PG8_SB(0, 1), cB + hstepB, voffB); PG8_STAGE(PG8_SA(0, 0), cA, voffA); PG8_STAGE(PG8_SA(0, 1), cA + hstepA, voffA);
        if (wr == 1) PG8_BAR;
        PG8_WAIT_V(2); PG8_BAR;
        PG8_STAGE(PG8_SB(1, 0), cB + kstep, voffB); PG8_STAGE(PG8_SA(1, 0), cA + kstep, voffA); PG8_STAGE(PG8_SB(1, 1), cB + hstepB + kstep, voffB);
        PG8_WAIT_V(6); PG8_BAR;
    } else {
        PG8_STAGE(PG8_SB(0, 0), cB, voffB); PG8_STAGE(PG8_SA(0, 0), cA, voffA); PG8_STAGE(PG8_SB(0, 1), cB + hstepB, voffB); PG8_STAGE(PG8_SA(0, 1), cA + hstepA, voffA);
        if (wr == 1) PG8_BAR;
        PG8_WAIT_V(4); PG8_BAR;
        PG8_STAGE(PG8_SB(1, 0), cB + kstep, voffB); PG8_STAGE(PG8_SA(1, 0), cA + kstep, voffA); PG8_STAGE(PG8_SB(1, 1), cB + hstepB + kstep, voffB);
        PG8_WAIT_V(6); PG8_BAR;
    }
    for (;;) {
        const bool has_next = S.next(ui + 1, nxt);
        const char* nA = has_next ? (const char*)g.A + (size_t)nxt.pm * tstepA : cA; const char* nB = has_next ? (const char*)g.Bt + (size_t)nxt.pn * tstepB : cB;
        for (int t = 0; t < nt; t += 2) {
            const bool last = (t == nt - 2);
            const char* a1 = cA + (size_t)(t + 1) * kstep;
            const char* a2 = last ? nA : cA + (size_t)(t + 2) * kstep; const char* b2 = last ? nB : cB + (size_t)(t + 2) * kstep;
            const char* a3 = a2 + kstep; const char* b3 = b2 + kstep;
            if (last && has_next) S.a_ready(nxt);
            if constexpr (SP2) {
            PG8_LDB(B0, 0, 0); PG8_LDB(B1, 0, 1); PG8_SCHED; PG8_LDA(At, 0, 0); PG8_STAGE(PG8_SA(1, 1), a1 + hstepA, voffA);
            PG8_WAIT_V(8); PG8_WAIT_L(0); PG8_BAR; PG8_MMA(0, 0, At, B0); PG8_MMA(0, 1, At, B1); PG8_BAR; PG8_SCHED;
            PG8_LDA(At, 0, 1); PG8_STAGE(PG8_SB(0, 0), b2, voffB); PG8_STAGE(PG8_SB(0, 1), b2 + hstepB, voffB); PG8_STAGE(PG8_SA(0, 0), a2, voffA);
            PG8_WAIT_V(8); PG8_WAIT_L(0); PG8_BAR; PG8_MMA(1, 0, At, B0); PG8_MMA(1, 1, At, B1); PG8_BAR; PG8_SCHED;
            PG8_LDB(B0, 1, 0); PG8_LDB(B1, 1, 1); PG8_SCHED; PG8_LDA(At, 1, 0); PG8_STAGE(PG8_SA(0, 1), a2 + hstepA, voffA);
            PG8_WAIT_V(8); PG8_WAIT_L(0); PG8_BAR; PG8_MMA(0, 0, At, B0); PG8_MMA(0, 1, At, B1); PG8_BAR; PG8_SCHED;
            PG8_LDA(At, 1, 1); PG8_STAGE(PG8_SB(1, 0), b3, voffB); PG8_STAGE(PG8_SB(1, 1), b3 + hstepB, voffB); PG8_STAGE(PG8_SA(1, 0), a3, voffA);
            PG8_WAIT_V(8); PG8_WAIT_L(0); PG8_BAR; PG8_MMA(1, 0, At, B0); PG8_MMA(1, 1, At, B1); PG8_BAR; PG8_SCHED;
            } else {
            PG8_LDB(B0, 0, 0); PG8_SCHED; PG8_LDA(At, 0, 0); PG8_STAGE(PG8_SA(1, 1), a1 + hstepA, voffA);
            PG8_WAIT_L(8); PG8_BAR; PG8_WAIT_L(0); PG8_MMA(0, 0, At, B0); PG8_BAR; PG8_SCHED;
            PG8_LDB(B1, 0, 1); PG8_STAGE(PG8_SB(0, 0), b2, voffB);
            PG8_BAR; PG8_WAIT_L(0); PG8_MMA(0, 1, At, B1); PG8_BAR;
            PG8_LDA(At, 0, 1); PG8_STAGE(PG8_SA(0, 0), a2, voffA);
            PG8_BAR; PG8_WAIT_L(0); PG8_MMA(1, 0, At, B0); PG8_BAR; PG8_SCHED;
            PG8_STAGE(PG8_SB(0, 1), b2 + hstepB, voffB);
            PG8_WAIT_V(6); PG8_BAR; PG8_MMA(1, 1, At, B1); PG8_BAR;
            PG8_LDB(B0, 1, 0); PG8_SCHED; PG8_LDA(At, 1, 0); PG8_STAGE(PG8_SA(0, 1), a2 + hstepA, voffA);
            PG8_WAIT_L(8); PG8_BAR; PG8_WAIT_L(0); PG8_MMA(0, 0, At, B0); PG8_BAR; PG8_SCHED;
            PG8_LDB(B1, 1, 1); PG8_STAGE(PG8_SB(1, 0), b3, voffB);
            PG8_BAR; PG8_WAIT_L(0); PG8_MMA(0, 1, At, B1); PG8_BAR;
            PG8_LDA(At, 1, 1); PG8_STAGE(PG8_SA(1, 0), a3, voffA);
            PG8_BAR; PG8_WAIT_L(0); PG8_MMA(1, 0, At, B0); PG8_BAR; PG8_SCHED;
            PG8_STAGE(PG8_SB(1, 1), b3 + hstepB, voffB);
            PG8_WAIT_V(6); PG8_BAR; PG8_MMA(1, 1, At, B1); PG8_BAR;
            }
        }
        if constexpr (ALIGN_EPI) { if (wr == 0) PG8_BAR; }
        if constexpr (!Epi::AFTER_DRAIN) { E(acc, cur, wr, wc, fr, fq); S.done(cur); }
        if (!has_next) break;
#pragma unroll
        for (int a = 0; a < 2; ++a)
#pragma unroll
            for (int b = 0; b < 2; ++b)
#pragma unroll
                for (int m = 0; m < 4; ++m)
#pragma unroll
                    for (int n = 0; n < 2; ++n) acc[a][b][m][n] = (f32x4){0.f, 0.f, 0.f, 0.f};
        cur = nxt; cA = nA; cB = nB; ++ui;
        if constexpr (ALIGN_EPI) { if (wr == 1) PG8_BAR; }
    }
    PG8_WAIT_V(0);
    if constexpr (!ALIGN_EPI) { if (wr == 0) PG8_BAR; }
    PG8_BAR;
    if constexpr (Epi::AFTER_DRAIN) { E.fused(acc, cur, wr, wc, fr, fq, lds, wid, lane); S.done(cur); }
#undef PG8_SA
#undef PG8_SB
#undef PG8_STAGE
#undef PG8_LDA
#undef PG8_LDB
#undef PG8_MMA
#undef PG8_WAIT_V
#undef PG8_WAIT_L
#undef PG8_BAR
#undef PG8_SCHED
}
}

using pg8::bf16x8; using pg8::f32x4; using pg8::u32x4; using pg8::cvt_pk_bf16;
typedef unsigned short bf16;
typedef float f32x16 __attribute__((ext_vector_type(16)));
typedef short s16x4 __attribute__((ext_vector_type(4)));
typedef unsigned u32x2 __attribute__((ext_vector_type(2)));

constexpr int DM = 4096, BATCH = 4, SEQ = 2048, T = BATCH * SEQ, FF = 6144, DEPTH = 4;
constexpr int MLA_H = 32, QLORA = 1024, KVLORA = 512, MLA_QK = 192, MLA_IN = 1600, MLA_IN_P = 1792;
constexpr int NSA_G = 4, HPG = 8, DH = 128, NKV = 3072, NSA_IN = 4192, NSA_IN_P = 4352;
constexpr int NCMP = 127, CMP_ROWS = BATCH * NCMP * NSA_G  , CMP_ROWS_P = 2048, CMP_HID = 256;
constexpr float EPS = 1e-6f, NEGF = -1e30f, LOG2E = 1.4426950408889634f;
constexpr int NWAVES = 8, NTHREADS = 512;

constexpr size_t MiB = 1u << 20;
constexpr size_t WS_CTL = 0, CTL_ZERO_BYTES = 64 * 1024;
constexpr int CW_BAR = 4096;
constexpr size_t SS_SLOT_B = (size_t)8192 * 64 * 4;
constexpr int SS_CQ = 12, SS_CKV = 14;
constexpr size_t FFN_GU_B = (size_t)2 * FF * DM * 2, FFN_D_B = (size_t)DM * FF * 2, FFN_B = FFN_GU_B + FFN_D_B;
constexpr size_t SS_OFF = 1 * MiB;
constexpr size_t WS_FFN = SS_OFF + 16 * SS_SLOT_B;
constexpr size_t WS_MLA = WS_FFN + 8 * FFN_B;
constexpr size_t MLA_WIN_B = (size_t)MLA_IN_P * DM * 2, MLA_WUQ_B = (size_t)6144 * QLORA * 2, MLA_WUKV_B = (size_t)8192 * KVLORA * 2, WO_B = (size_t)DM * DM * 2;
constexpr size_t MLA_B = MLA_WIN_B + MLA_WUQ_B + MLA_WUKV_B + WO_B;
constexpr size_t WS_NSA = WS_MLA + 2 * MLA_B;
constexpr size_t NSA_WIN_B = (size_t)NSA_IN_P * DM * 2, NSA_B = NSA_WIN_B + WO_B;
constexpr size_t WS_KVW = WS_NSA + 2 * NSA_B, KVW_B = (size_t)NKV * DM * 2;
constexpr size_t WS_CW1 = WS_KVW + KVW_B, CW1_B = (size_t)CMP_HID * 4096 * 2;
constexpr size_t WS_HB = WS_CW1 + 2 * CW1_B;
constexpr size_t WS_ACT = WS_HB + (size_t)T * DM * 2;
constexpr size_t WS_CBUF = WS_ACT + (size_t)T * FF * 2;
constexpr size_t WS_QRAW = WS_CBUF + (size_t)T * MLA_IN_P * 2;
constexpr size_t WS_KVRAW = WS_QRAW + (size_t)T * 6144 * 2;
constexpr size_t WS_QF = WS_KVRAW + (size_t)T * 8192 * 2;
constexpr size_t WS_KF = WS_QF + (size_t)T * 32 * 192 * 2;
constexpr size_t WS_OB = WS_KF + (size_t)T * 32 * 192 * 2;
constexpr size_t WS_GATES = WS_OB + (size_t)T * DM * 2;
constexpr size_t WS_SEL = WS_GATES + (size_t)T * 96 * 4;
constexpr size_t WS_KVS = WS_SEL + (size_t)BATCH * NSA_G * SEQ * 4;
constexpr size_t WS_KSLC = WS_KVS + (size_t)T * NKV * 4;
constexpr size_t WS_KWIN = WS_KSLC + (size_t)T * 512 * 2, WS_VSLC = WS_KWIN + (size_t)T * 512 * 2, WS_VWIN = WS_VSLC + (size_t)T * 512 * 2;
constexpr size_t WS_BLKK = WS_VWIN + (size_t)T * 512 * 2, WS_BLKV = WS_BLKK + (size_t)CMP_ROWS_P * 4096 * 2;
constexpr size_t WS_HIDK = WS_BLKV + (size_t)CMP_ROWS_P * 4096 * 2, WS_HIDV = WS_HIDK + (size_t)CMP_ROWS_P * 256 * 2;
constexpr size_t WS_KC = WS_HIDV + (size_t)CMP_ROWS_P * 256 * 2, WS_VC = WS_KC + (size_t)16 * 128 * 128 * 2;
constexpr size_t WS_TABA = WS_VC + (size_t)16 * 128 * 128 * 2;
constexpr size_t WS_TABB = WS_TABA + (size_t)T * 32 * 4 * 2;
constexpr size_t WS_GP = WS_TABB + (size_t)T * 64 * 4 * 2;
constexpr size_t WS_END = WS_GP + (size_t)8 * T * 96 * 4;
constexpr size_t NSA_WQ_B = (size_t)4096 * DM * 2, GSL_B = (size_t)256 * 512 * 2;
static_assert((CW_BAR + 3456) * 4 <= (int)CTL_ZERO_BYTES && CTL_ZERO_BYTES <= SS_OFF, "zeroed region");
static_assert(WS_HB % 256 == 0 && WS_END < ((size_t)3000 << 20), "d_ws map");

constexpr int RING_BYTES = 131072;
constexpr int LDSCTL_OFF = RING_BYTES, MISC_OFF = LDSCTL_OFF + 320, RSTAB_OFF = LDSCTL_OFF + 1024;
constexpr int LDS_BYTES = 147456;

#define GAS __attribute__((address_space(1)))
#define LAS __attribute__((address_space(3)))
#define RLX_AGENT __ATOMIC_RELAXED, __HIP_MEMORY_SCOPE_AGENT
#define LDS_WAIT() asm volatile("s_waitcnt lgkmcnt(0)" ::: "memory")
__device__ __forceinline__ unsigned f2bf(float f) { unsigned u = __builtin_bit_cast(unsigned, f); return (u + 0x7fffu + ((u >> 16) & 1u)) >> 16; }
__device__ __forceinline__ unsigned pk2(float lo, float hi) { return f2bf(lo) | (f2bf(hi) << 16); }
__device__ __forceinline__ float bf2f(bf16 b) { return __builtin_bit_cast(float, (unsigned)b << 16); }
using pg8::shx; using pg8::shxu;
__device__ __forceinline__ float wave_sum(float v, int lane) {
#pragma unroll
    for (int o = 1; o < 64; o <<= 1) v += shx(v, o, lane);
    return v;
}

#define XB_TMO      128
#define XB_XCNT(j)  (256  + 64 * (j))
#define XB_XSUB(j)  (1280 + 64 * (j))
#define XB_XGEN(j)  (2304 + 64 * (j))
#define XB_TOP      3328
#define XB_TOPGEN   3392
#define XCD_BAR_WORDS 3456
#define XB_SPIN_CAP (1u << 18)

__device__ __forceinline__ unsigned xb_ld(unsigned* p)              { return __hip_atomic_load(p, __ATOMIC_RELAXED, __HIP_MEMORY_SCOPE_AGENT); }
__device__ __forceinline__ unsigned xb_add(unsigned* p, unsigned v) { return __hip_atomic_fetch_add(p, v, __ATOMIC_RELAXED, __HIP_MEMORY_SCOPE_AGENT); }
__device__ __forceinline__ unsigned xb_xcc_id() { return (unsigned)__builtin_amdgcn_s_getreg((3 << 11) | 20) & 0xFu; }
#define XB_SPIN(cond, bar) do { unsigned _sp = 0; while (cond) { __builtin_amdgcn_s_sleep(1); \
    if ((++_sp & 255u) == 0u) { if (xb_ld(&(bar)[XB_TMO])) break; if (_sp > XB_SPIN_CAP) { atomicAdd(&(bar)[XB_TMO], 1u); break; } } } } while (0)

struct XcdBarrier {
    unsigned* bar; unsigned x;
    volatile LAS unsigned* st;
};

__device__ __forceinline__ XcdBarrier xcd_barrier_post(unsigned* bar, volatile LAS unsigned* st) {
    XcdBarrier b; b.bar = bar; b.x = xb_xcc_id(); b.st = st;
    if (threadIdx.x == 0) (void)xb_add(&bar[XB_XCNT(b.x)], 1u);
    return b;
}
__device__ __forceinline__ void xcd_barrier_complete(unsigned* bar, unsigned x, unsigned& nloc, unsigned& nx) {
    const unsigned G = gridDim.x * gridDim.y * gridDim.z;
    unsigned sum, cnt, mine, sp = 0u;
    for (;;) {
        sum = 0u; cnt = 0u; mine = 0u;
#pragma unroll
        for (unsigned j = 0; j < 16; ++j) { const unsigned c = xb_ld(&bar[XB_XCNT(j)]); sum += c; cnt += (c > 0u) ? 1u : 0u; mine = (j == x) ? c : mine; }
        if (sum == G) break;
        __builtin_amdgcn_s_sleep(1);
        if ((++sp & 255u) == 0u) { if (xb_ld(&bar[XB_TMO])) break; if (sp > XB_SPIN_CAP) { atomicAdd(&bar[XB_TMO], 1u); break; } }
    }
    nloc = mine > 0u ? mine : 1u; nx = cnt > 0u ? cnt : 1u;
}

__device__ __forceinline__ void xcd_barrier(const XcdBarrier& b) {
    asm volatile("s_waitcnt vmcnt(0)" ::: "memory");
    __syncthreads();
    if (threadIdx.x == 0) {
        unsigned* bar = b.bar;
        __builtin_amdgcn_s_waitcnt(0);
        unsigned nloc = b.st[0], nx = b.st[1];
        if (nloc == 0u) { xcd_barrier_complete(bar, b.x, nloc, nx); b.st[0] = nloc; b.st[1] = nx; }
        const unsigned old = xb_add(&bar[XB_XSUB(b.x)], 1u);
        const unsigned gen = old / nloc;
        if (old + 1u == (gen + 1u) * nloc) {
            __builtin_amdgcn_fence(__ATOMIC_RELEASE, "agent");
            asm volatile("s_waitcnt vmcnt(0)" ::: "memory");
            const unsigned og = xb_add(&bar[XB_TOP], 1u);
            const unsigned tg = og / nx;
            if (og + 1u == (tg + 1u) * nx) xb_add(&bar[XB_TOPGEN], 1u);
            else XB_SPIN(xb_ld(&bar[XB_TOPGEN]) == tg, bar);
            __builtin_amdgcn_fence(__ATOMIC_ACQUIRE, "agent");
            xb_add(&bar[XB_XGEN(b.x)], 1u);
            asm volatile("s_waitcnt vmcnt(0)" ::: "memory");
        } else {
            XB_SPIN(xb_ld(&bar[XB_XGEN(b.x)]) == gen, bar);
            __builtin_amdgcn_fence(__ATOMIC_ACQUIRE, "agent");
            asm volatile("s_waitcnt vmcnt(0)" ::: "memory");
        }
    }
    __syncthreads();
}

typedef GAS unsigned gu32;

struct Args { const void* in[36]; float* out; unsigned char* ws; int ph_lo, ph_hi; };
enum { I_X = 0, I_POS, I_F1N, I_F1G, I_F1U, I_F1D, I_MIXN, I_F2N, I_F2G, I_F2U, I_F2D, I_MWIN, I_MGCQ, I_MGCKV, I_MWUQ, I_MWUKV, I_MGQ, I_MGK, I_MWO,
       I_KVN, I_KVW, I_CPK, I_CPV, I_CKW1, I_CKB1, I_CKW2, I_CVW1, I_CVB1, I_CVW2, I_GKC, I_GKS, I_GKW, I_NWIN, I_NBG, I_NGQ, I_NWO };

struct CvtJob { const float* W; const float* gain; bf16* WT; int K, N, mode, ldw; };
constexpr int N_CVT_JOBS = 42;
template <class ArgsT> __device__ __forceinline__ CvtJob get_job(const ArgsT& a, int j) {
    CvtJob jb; unsigned char* ws = a.ws; jb.ldw = 0;
    if (j < 24) { const int l = j / 6, r = j % 6, which = r / 3, mat = r % 3;
        const float* norm = (const float*)a.in[which ? I_F2N : I_F1N] + (size_t)l * DM;
        bf16* gu = (bf16*)(ws + WS_FFN + (size_t)(l * 2 + which) * FFN_B);
        if (mat == 0)      { jb.W = (const float*)a.in[which ? I_F2G : I_F1G] + (size_t)l * DM * FF; jb.gain = norm; jb.WT = gu; jb.K = DM; jb.N = FF; jb.mode = 1; }
        else if (mat == 1) { jb.W = (const float*)a.in[which ? I_F2U : I_F1U] + (size_t)l * DM * FF; jb.gain = norm; jb.WT = gu; jb.K = DM; jb.N = FF; jb.mode = 2; }
        else               { jb.W = (const float*)a.in[which ? I_F2D : I_F1D] + (size_t)l * FF * DM; jb.gain = nullptr; jb.WT = (bf16*)((unsigned char*)gu + FFN_GU_B); jb.K = FF; jb.N = DM; jb.mode = 0; }
    } else if (j < 32) { const int l = (j - 24) / 4, r = (j - 24) % 4; unsigned char* base = ws + WS_MLA + (size_t)l * MLA_B; jb.mode = 0;
        if (r == 0)      { jb.W = (const float*)a.in[I_MWIN] + (size_t)l * DM * MLA_IN; jb.gain = (const float*)a.in[I_MIXN] + (size_t)l * DM; jb.WT = (bf16*)base; jb.K = DM; jb.N = MLA_IN; }
        else if (r == 1) { jb.W = (const float*)a.in[I_MWUQ] + (size_t)l * QLORA * 6144; jb.gain = (const float*)a.in[I_MGCQ] + (size_t)l * QLORA; jb.WT = (bf16*)(base + MLA_WIN_B); jb.K = QLORA; jb.N = 6144; }
        else if (r == 2) { jb.W = (const float*)a.in[I_MWUKV] + (size_t)l * KVLORA * 8192; jb.gain = (const float*)a.in[I_MGCKV] + (size_t)l * KVLORA; jb.WT = (bf16*)(base + MLA_WIN_B + MLA_WUQ_B); jb.K = KVLORA; jb.N = 8192; }
        else             { jb.W = (const float*)a.in[I_MWO] + (size_t)l * DM * DM; jb.gain = nullptr; jb.WT = (bf16*)(base + MLA_WIN_B + MLA_WUQ_B + MLA_WUKV_B); jb.K = DM; jb.N = DM; }
    } else if (j < 38) { const int l = (j - 32) / 3, r = (j - 32) % 3; unsigned char* base = ws + WS_NSA + (size_t)l * NSA_B; jb.mode = 0;
        if (r == 0)      { jb.W = (const float*)a.in[I_NWIN] + (size_t)l * DM * NSA_IN; jb.gain = (const float*)a.in[I_MIXN] + (size_t)(2 + l) * DM; jb.WT = (bf16*)base; jb.K = DM; jb.N = 4096; jb.ldw = NSA_IN; }
        else if (r == 1) { jb.W = (const float*)a.in[I_NWIN] + (size_t)l * DM * NSA_IN + 4096; jb.gain = (const float*)a.in[I_MIXN] + (size_t)(2 + l) * DM; jb.WT = (bf16*)(base + NSA_WQ_B); jb.K = DM; jb.N = 96; jb.ldw = NSA_IN; jb.mode = 3; }
        else             { jb.W = (const float*)a.in[I_NWO] + (size_t)l * DM * DM; jb.gain = nullptr; jb.WT = (bf16*)(base + NSA_WIN_B); jb.K = DM; jb.N = DM; }
    } else if (j == 38) { jb.W = (const float*)a.in[I_KVW]; jb.gain = (const float*)a.in[I_KVN]; jb.WT = (bf16*)(ws + WS_KVW); jb.K = DM; jb.N = 2048; jb.ldw = NKV; jb.mode = 0; }
    else if (j == 41)   { jb.W = (const float*)a.in[I_KVW] + 2048; jb.gain = (const float*)a.in[I_KVN]; jb.WT = (bf16*)(ws + WS_KVW + (size_t)2048 * DM * 2); jb.K = DM; jb.N = 1024; jb.ldw = NKV; jb.mode = 4; }
    else if (j == 39)   { jb.W = (const float*)a.in[I_CKW1]; jb.gain = nullptr; jb.WT = (bf16*)(ws + WS_CW1); jb.K = 4096; jb.N = CMP_HID; jb.mode = 3; }
    else if (j == 40)   { jb.W = (const float*)a.in[I_CVW1]; jb.gain = nullptr; jb.WT = (bf16*)(ws + WS_CW1 + CW1_B); jb.K = 4096; jb.N = CMP_HID; jb.mode = 3; }
    if (jb.ldw == 0) jb.ldw = jb.N;
    return jb;
}
__device__ __forceinline__ void cvt_item(const float* W, const float* gain, bf16* WT, int K, int N, int ldw, int mode, LAS float* scr, int item, int lane) {
    const int nblk = N / 32, kb = item / nblk, nb = item - kb * nblk, k0 = 64 * kb, n0 = 32 * nb;
    float wv[32];
#pragma unroll
    for (int i = 0; i < 32; ++i) wv[i] = __builtin_nontemporal_load(&W[(size_t)(k0 + 2 * i + (lane >> 5)) * ldw + n0 + (lane & 31)]);
    if (gain) {
#pragma unroll
        for (int i = 0; i < 32; ++i) wv[i] *= gain[k0 + 2 * i + (lane >> 5)]; }
#pragma unroll
    for (int i = 0; i < 32; ++i) scr[(2 * i + (lane >> 5)) * 33 + (lane & 31)] = wv[i];
    LDS_WAIT(); asm volatile("" ::: "memory");
    const int c = lane & 7;
    const int drow0 = (mode == 0) ? n0 : (256 * (n0 >> 7) + (n0 & 127) + (mode == 2 ? 128 : 0));
#pragma unroll
    for (int j = 0; j < 4; ++j) { const int n = (lane >> 3) + 8 * j; const LAS float* s = scr + (8 * c) * 33 + n;
        u32x4 o; o.x = pk2(s[0 * 33], s[1 * 33]); o.y = pk2(s[2 * 33], s[3 * 33]); o.z = pk2(s[4 * 33], s[5 * 33]); o.w = pk2(s[6 * 33], s[7 * 33]);
        bf16* dst = (mode == 3) ? WT + (size_t)(k0 >> 9) * (256 * 512) + (size_t)(n0 + n) * 512 + (k0 & 511) + 8 * c
                  : (mode == 4) ? WT + (size_t)(k0 >> 11) * (1024 * 2048) + (size_t)(n0 + n) * 2048 + (k0 & 2047) + 8 * c : WT + (size_t)(drow0 + n) * K + k0 + 8 * c;
        *(GAS u32x4*)dst = o; }
    LDS_WAIT(); asm volatile("" ::: "memory");
}
__device__ __forceinline__ void cvt_load(float (&wv)[32], float& gv, const CvtJob& jb, int item, int lane) {
    const int nblk = jb.N / 32, kb = item / nblk, nb = item - kb * nblk, k0 = 64 * kb, n0 = 32 * nb;
    const float* p = jb.W + (size_t)(k0 + (lane >> 5)) * jb.ldw + n0 + (lane & 31);
#pragma unroll
    for (int i = 0; i < 32; ++i) wv[i] = __builtin_nontemporal_load(p + (size_t)(2 * i) * jb.ldw);
    gv = jb.gain ? jb.gain[k0 + lane] : 1.0f;
}
__device__ __forceinline__ void cvt_finish(float (&wv)[32], const float gv, const CvtJob& jb, int item, LAS float* scr, int lane) {
    const int nblk = jb.N / 32, kb = item / nblk, nb = item - kb * nblk, k0 = 64 * kb, n0 = 32 * nb, mode = jb.mode, K = jb.K;
    if (jb.gain) {
#pragma unroll
        for (int i = 0; i < 32; ++i) wv[i] *= __builtin_bit_cast(float, __builtin_amdgcn_ds_bpermute((2 * i + (lane >> 5)) * 4, __builtin_bit_cast(int, gv))); }
#pragma unroll
    for (int i = 0; i < 32; ++i) scr[(2 * i + (lane >> 5)) * 33 + (lane & 31)] = wv[i];
    LDS_WAIT(); asm volatile("" ::: "memory");
    const int c = lane & 7;
    const int drow0 = (mode == 0) ? n0 : (256 * (n0 >> 7) + (n0 & 127) + (mode == 2 ? 128 : 0));
#pragma unroll
    for (int j = 0; j < 4; ++j) { const int n = (lane >> 3) + 8 * j; const LAS float* s = scr + (8 * c) * 33 + n;
        u32x4 o; o.x = pk2(s[0 * 33], s[1 * 33]); o.y = pk2(s[2 * 33], s[3 * 33]); o.z = pk2(s[4 * 33], s[5 * 33]); o.w = pk2(s[6 * 33], s[7 * 33]);
        bf16* dst = (mode == 3) ? jb.WT + (size_t)(k0 >> 9) * (256 * 512) + (size_t)(n0 + n) * 512 + (k0 & 511) + 8 * c
                  : (mode == 4) ? jb.WT + (size_t)(k0 >> 11) * (1024 * 2048) + (size_t)(n0 + n) * 2048 + (k0 & 2047) + 8 * c : jb.WT + (size_t)(drow0 + n) * K + k0 + 8 * c;
        *(GAS u32x4*)dst = o; }
    LDS_WAIT(); asm volatile("" ::: "memory");
}
template <class ArgsT> __device__ __forceinline__ bool cvt_next(const ArgsT& a, int& j, const int jend, int& it, CvtJob& jb, const int gw) {
    while (j < jend) { jb = get_job(a, j); if (it < (jb.K / 64) * (jb.N / 32)) return true; ++j; it = gw; }
    return false;
}
template <class ArgsT> __device__ __forceinline__ void cvt_range(const ArgsT& a, const int j0, const int n, LAS unsigned char* lds, int gw, int NGW, int wave, int lane) {
    LAS float* scr = (LAS float*)(lds + wave * 16384);
    int j = j0, it = gw; const int jend = j0 + n; CvtJob ja, jb; float wa[32], wb[32], ga = 1.0f, gb = 1.0f;
    bool va = cvt_next(a, j, jend, it, ja, gw); int ita = it, itb = 0; if (va) cvt_load(wa, ga, ja, ita, lane);
    while (va) {
        it += NGW; const bool vb = cvt_next(a, j, jend, it, jb, gw); itb = it; if (vb) cvt_load(wb, gb, jb, itb, lane);
        cvt_finish(wa, ga, ja, ita, scr, lane);
        if (!vb) break;
        it += NGW; va = cvt_next(a, j, jend, it, ja, gw); ita = it; if (va) cvt_load(wa, ga, ja, ita, lane);
        cvt_finish(wb, gb, jb, itb, scr, lane);
    }
}
__device__ __forceinline__ void zero_fill16(void* p, size_t bytes, int gtid, int gthreads) {
    u32x4* q = (u32x4*)p; const size_t n = bytes / 16; const u32x4 z = {0u, 0u, 0u, 0u};
    for (size_t i = gtid; i < n; i += gthreads) q[i] = z;
}
template <class ArgsT> __device__ __forceinline__ void prologue(const ArgsT& a, LAS unsigned char* lds, int vcu, int G, int wave, int lane, int tid) {
    unsigned char* ws = a.ws;
    LAS float* scr = (LAS float*)(lds + wave * 16384);
    const int gw = vcu * NWAVES + wave, NGW = G * NWAVES, gtid = gw * 64 + lane, gthreads = NGW * 64;
    cvt_range(a, 0, 2, lds, gw, NGW, wave, lane);
    for (int l = 0; l < 2; ++l) {
        zero_fill16(ws + WS_MLA + (size_t)l * MLA_B + (size_t)MLA_IN * DM * 2, (size_t)(MLA_IN_P - MLA_IN) * DM * 2, gtid, gthreads);
        for (int s = 0; s < 8; ++s) zero_fill16(ws + WS_NSA + (size_t)l * NSA_B + NSA_WQ_B + (size_t)s * GSL_B + (size_t)96 * 512 * 2, (size_t)160 * 512 * 2, gtid, gthreads); }
    { const int* pos = (const int*)a.in[I_POS]; float* ta = (float*)(ws + WS_TABA); float* tb = (float*)(ws + WS_TABB);
      for (int i = gtid; i < T * 32; i += gthreads) { const int t = i >> 5, f = i & 31; const float inv = powf(10000.0f, -(float)(2 * f) / 64.0f); const float ang = (float)pos[t] * inv;
          float sn, cs; sincosf(ang, &sn, &cs); ta[i] = cs; ta[T * 32 + i] = sn; }
      for (int i = gtid; i < T * 64; i += gthreads) { const int t = i >> 6, f = i & 63; const float inv = powf(10000.0f, -(float)(2 * f) / 128.0f); const float ang = (float)pos[t] * inv;
          float sn, cs; sincosf(ang, &sn, &cs); tb[i] = cs; tb[T * 64 + i] = sn; } }
    { const float* x = (const float*)a.in[I_X]; bf16* hb = (bf16*)(ws + WS_HB); float* ss0 = (float*)(ws + SS_OFF);
      for (int m = gw; m < T; m += NGW) { const f32x4* xr = (const f32x4*)(x + (size_t)m * DM) + lane; u32x2* o8 = (u32x2*)(hb + (size_t)m * DM) + lane; float s = 0.f;
#pragma unroll 4
          for (int j = 0; j < 16; ++j) { const f32x4 v = __builtin_nontemporal_load(&xr[64 * j]); s += pg8::quad_sq(v); u32x2 w; w.x = pk2(v[0], v[1]); w.y = pk2(v[2], v[3]); o8[64 * j] = w; }
          s = wave_sum(s, lane); if (lane == 0) ss0[(size_t)m * 64] = s; } }
}

constexpr float QS_MLA = 0.07216878364870322f * LOG2E;
constexpr float QS_NSA = 0.08838834764831845f * LOG2E;
__device__ __forceinline__ void unpack8(const u32x4 w, float (&v)[8]) {
    v[0] = __builtin_bit_cast(float, w.x << 16); v[1] = __builtin_bit_cast(float, w.x & 0xffff0000u); v[2] = __builtin_bit_cast(float, w.y << 16); v[3] = __builtin_bit_cast(float, w.y & 0xffff0000u);
    v[4] = __builtin_bit_cast(float, w.z << 16); v[5] = __builtin_bit_cast(float, w.z & 0xffff0000u); v[6] = __builtin_bit_cast(float, w.w << 16); v[7] = __builtin_bit_cast(float, w.w & 0xffff0000u);
}
__device__ __forceinline__ u32x4 pack8(const float (&v)[8]) { u32x4 w; w.x = cvt_pk_bf16(v[0], v[1]); w.y = cvt_pk_bf16(v[2], v[3]); w.z = cvt_pk_bf16(v[4], v[5]); w.w = cvt_pk_bf16(v[6], v[7]); return w; }
__device__ __forceinline__ void mla_k_finalize(const bf16* kvraw, const bf16* cbuf, const float* gk, const float* tabA, bf16* Kf, int gw, int NGW, int lane) {
    const int hd8 = lane >> 3, c = lane & 7;
    float g0[8], g1[8], g2[8];
#pragma unroll
    for (int i = 0; i < 8; ++i) { g0[i] = gk[c * 16 + i]; g1[i] = gk[c * 16 + 8 + i]; g2[i] = gk[128 + c * 8 + i]; }
    for (int it = gw; it < T * 4; it += NGW) { const int tok = it >> 2, head = (it & 3) * 8 + hd8;
        const bf16* kp = kvraw + (size_t)tok * 8192 + head * 256 + c * 16;
        const u32x4 w0 = *(const u32x4*)kp, w1 = *(const u32x4*)(kp + 8), wr = *(const u32x4*)(cbuf + (size_t)tok * MLA_IN_P + 1536 + c * 8);
        const f32x4 cs0 = *(const f32x4*)(tabA + tok * 32 + 8 * (c & 3)), cs1 = *(const f32x4*)(tabA + tok * 32 + 8 * (c & 3) + 4);
        const f32x4 sn0 = *(const f32x4*)(tabA + T * 32 + tok * 32 + 8 * (c & 3)), sn1 = *(const f32x4*)(tabA + T * 32 + tok * 32 + 8 * (c & 3) + 4);
        float a[8], bq[8], r8[8]; unpack8(w0, a); unpack8(w1, bq); unpack8(wr, r8);
        float ss = 0.f;
#pragma unroll
        for (int i = 0; i < 8; ++i) ss += a[i] * a[i] + bq[i] * bq[i] + r8[i] * r8[i];
        ss += shx(ss, 1, lane); ss += shx(ss, 2, lane); ss += shx(ss, 4, lane);
        const float r = __builtin_amdgcn_rsqf(ss * (1.0f / 192.0f) + EPS);
        float o[8];
#pragma unroll
        for (int i = 0; i < 8; ++i) { a[i] *= r * g0[i]; bq[i] *= r * g1[i]; r8[i] *= r * g2[i]; }
#pragma unroll
        for (int i = 0; i < 8; ++i) { const float p = shx(r8[i], 4, lane); const float cs = i < 4 ? cs0[i & 3] : cs1[i & 3], sn = i < 4 ? sn0[i & 3] : sn1[i & 3];
            o[i] = (c < 4) ? (r8[i] * cs - p * sn) : (r8[i] * cs + p * sn); }
        bf16* op = Kf + ((size_t)tok * 32 + head) * 192;
        *(u32x4*)(op + c * 16) = pack8(a); *(u32x4*)(op + c * 16 + 8) = pack8(bq); *(u32x4*)(op + 128 + c * 8) = pack8(o);
    }
}
__device__ __forceinline__ void ld16f(float (&x)[16], const float* p) {
#pragma unroll
    for (int q = 0; q < 4; ++q) { const f32x4 v = *(const f32x4*)(p + 4 * q); x[4 * q] = v[0]; x[4 * q + 1] = v[1]; x[4 * q + 2] = v[2]; x[4 * q + 3] = v[3]; } }
__device__ __forceinline__ void st16bf(bf16* p, const float (&x)[16]) {
    u32x4 a, c2; a.x = cvt_pk_bf16(x[0], x[1]); a.y = cvt_pk_bf16(x[2], x[3]); a.z = cvt_pk_bf16(x[4], x[5]); a.w = cvt_pk_bf16(x[6], x[7]);
    c2.x = cvt_pk_bf16(x[8], x[9]); c2.y = cvt_pk_bf16(x[10], x[11]); c2.z = cvt_pk_bf16(x[12], x[13]); c2.w = cvt_pk_bf16(x[14], x[15]);
    *(u32x4*)p = a; *(u32x4*)(p + 8) = c2; }
template <class ArgsT> __device__ __forceinline__ void nsa_kv_finalize(const ArgsT& a, int gw, int NGW, int lane) {
    unsigned char* ws = a.ws; const float* kvs = (const float*)(ws + WS_KVS); const float* tabB = (const float*)(ws + WS_TABB);
    bf16* Ks = (bf16*)(ws + WS_KSLC); bf16* Kw = (bf16*)(ws + WS_KWIN); bf16* Vs = (bf16*)(ws + WS_VSLC); bf16* Vw = (bf16*)(ws + WS_VWIN);
    const int v = lane >> 3, c = lane & 7, g = v & 3; const bool win = v >= 4;
    float gn[16]; ld16f(gn, (const float*)a.in[win ? I_GKW : I_GKS] + c * 16);
    for (int tok = gw; tok < T; tok += NGW) { const float* row = kvs + (size_t)tok * NKV; const size_t o = (size_t)tok * 512 + g * 128 + c * 16;
        const float* wp = (const float*)(ws + WS_ACT) + (size_t)tok * 1024 + g * 128 + c * 16;
        float x[16], cs[16], sn[16];
        if (win) { float x2[16]; ld16f(x, wp); ld16f(x2, wp + (size_t)T * 1024);
#pragma unroll
            for (int i = 0; i < 16; ++i) x[i] += x2[i]; }
        else ld16f(x, row + 2 * 512 + g * 128 + c * 16); ld16f(cs, tabB + tok * 64 + (c & 3) * 16); ld16f(sn, tabB + T * 64 + tok * 64 + (c & 3) * 16);
        float ss = 0.f;
#pragma unroll
        for (int i = 0; i < 16; ++i) ss += x[i] * x[i];
        ss += shx(ss, 1, lane); ss += shx(ss, 2, lane); ss += shx(ss, 4, lane);
        const float r = __builtin_amdgcn_rsqf(ss * (1.0f / 128.0f) + EPS);
#pragma unroll
        for (int i = 0; i < 16; ++i) { x[i] *= r * gn[i]; const float p = shx(x[i], 4, lane); x[i] = (c < 4) ? (x[i] * cs[i] - p * sn[i]) : (x[i] * cs[i] + p * sn[i]); }
        st16bf((win ? Kw : Ks) + o, x);
        float y[16];
        if (win) { float y2[16]; ld16f(y, wp + 512); ld16f(y2, wp + 512 + (size_t)T * 1024);
#pragma unroll
            for (int i = 0; i < 16; ++i) y[i] += y2[i]; }
        else ld16f(y, row + 3 * 512 + g * 128 + c * 16);
        st16bf((win ? Vw : Vs) + o, y);
    }
    bf16* bk = (bf16*)(ws + WS_BLKK); bf16* bv = (bf16*)(ws + WS_BLKV); const float* pk = (const float*)a.in[I_CPK]; const float* pv = (const float*)a.in[I_CPV];
    for (int rho = gw; rho < CMP_ROWS_P; rho += NGW) {
        if (rho < CMP_ROWS) { const int b = rho / (NCMP * NSA_G), rem = rho - b * (NCMP * NSA_G), n = rem >> 2, gg = rem & 3;
            for (int l0 = 0; l0 < 32; l0 += 8) { const int l = l0 + v; const float* row = kvs + (size_t)(b * SEQ + 16 * n + l) * NKV + gg * 128 + c * 16; const size_t o = (size_t)rho * 4096 + l * 128 + c * 16;
                float x[16], p[16]; ld16f(x, row); ld16f(p, pk + l * 128 + c * 16);
#pragma unroll
                for (int i = 0; i < 16; ++i) x[i] += p[i];
                st16bf(bk + o, x);
                ld16f(x, row + 512); ld16f(p, pv + l * 128 + c * 16);
#pragma unroll
                for (int i = 0; i < 16; ++i) x[i] += p[i];
                st16bf(bv + o, x); }
        } else { const u32x4 z = {0u, 0u, 0u, 0u}; for (int c8 = lane; c8 < 512; c8 += 64) { *(u32x4*)(bk + (size_t)rho * 4096 + c8 * 8) = z; *(u32x4*)(bv + (size_t)rho * 4096 + c8 * 8) = z; } }
    }
}
template <class ArgsT> __device__ __forceinline__ void nsa_cmp_out(const ArgsT& a, LAS unsigned char* lds, int gw, int NGW, int wave, int lane) {
    unsigned char* ws = a.ws; const float* P = (const float*)(ws + WS_KVS); bf16* Kc = (bf16*)(ws + WS_KC); bf16* Vc = (bf16*)(ws + WS_VC);
    const float* w2k = (const float*)a.in[I_CKW2]; const float* w2v = (const float*)a.in[I_CVW2]; const float* gkc = (const float*)a.in[I_GKC];
    const float* b1k = (const float*)a.in[I_CKB1]; const float* b1v = (const float*)a.in[I_CVB1];
    LAS float* hs = (LAS float*)(lds + wave * 4096);
    for (int rho = gw; rho < CMP_ROWS; rho += NGW) {
#pragma unroll
        for (int i = 0; i < 4; ++i) { const int j = lane + 64 * i; float sk = b1k[j], sv = b1v[j];
#pragma unroll
            for (int s = 0; s < 8; ++s) { sk += P[((size_t)s * CMP_ROWS_P + rho) * 256 + j]; sv += P[((size_t)(8 + s) * CMP_ROWS_P + rho) * 256 + j]; }
            hs[j] = pg8::silu_f(sk); hs[256 + j] = pg8::silu_f(sv); }
        LDS_WAIT(); asm volatile("" ::: "memory");
        float k0 = 0.f, k1 = 0.f, v0 = 0.f, v1 = 0.f;
#pragma unroll 8
        for (int j = 0; j < CMP_HID; ++j) { const float xk = hs[j], xv = hs[256 + j];
            k0 += xk * w2k[j * 128 + lane]; k1 += xk * w2k[j * 128 + 64 + lane]; v0 += xv * w2v[j * 128 + lane]; v1 += xv * w2v[j * 128 + 64 + lane]; }
        const float r = __builtin_amdgcn_rsqf(wave_sum(k0 * k0 + k1 * k1, lane) * (1.0f / 128.0f) + EPS);
        const int b = rho / (NCMP * NSA_G), rem = rho - b * (NCMP * NSA_G), n = rem >> 2, g = rem & 3; const size_t o = ((size_t)(b * 4 + g) * 128 + n) * 128;
        Kc[o + lane] = (bf16)f2bf(k0 * r * gkc[lane]); Kc[o + 64 + lane] = (bf16)f2bf(k1 * r * gkc[64 + lane]); Vc[o + lane] = (bf16)f2bf(v0); Vc[o + 64 + lane] = (bf16)f2bf(v1);
        LDS_WAIT(); asm volatile("" ::: "memory"); }
    for (int i = gw; i < 16; i += NGW) { const size_t o = ((size_t)i * 128 + 127) * 128; Kc[o + lane] = 0; Kc[o + 64 + lane] = 0; Vc[o + lane] = 0; Vc[o + 64 + lane] = 0; }
}
#ifndef MK_SENS
#define MK_SENS 0
#endif
struct AttnSt { f32x16 o[4]; float m, l; };
template <int DQK> struct ACfg { static constexpr int KSTR = DQK * 2 + 16, KBYTES = 64 * KSTR, VSTR = 320, VBYTES = 64 * VSTR, STAGE = KBYTES + VBYTES, NCK = DQK / 64, NSTEP = DQK / 16,
    KCH = KSTR / 16, VCH = VSTR / 16, NDMA = KCH + VCH  , NI = (NDMA + 7) / 8  ; };
typedef short v4i16_t __attribute__((ext_vector_type(4)));
__device__ __forceinline__ s16x4 vtr(const LAS unsigned char* p) { return __builtin_bit_cast(s16x4, __builtin_amdgcn_ds_read_tr16_b64_v4i16((LAS v4i16_t*)p)); }
__device__ __forceinline__ float xmax32(float x) { float a = x, c = x; asm volatile("s_nop 1\n\tv_permlane32_swap_b32 %0, %1" : "+v"(a), "+v"(c)); return fmaxf(a, c); }
__device__ __forceinline__ float xsum32(float x) { float a = x, c = x; asm volatile("s_nop 1\n\tv_permlane32_swap_b32 %0, %1" : "+v"(a), "+v"(c)); return a + c; }
typedef float f32x2_t __attribute__((ext_vector_type(2))); typedef __bf16 bf16x2_t __attribute__((ext_vector_type(2)));
__device__ __forceinline__ unsigned cvtpk(float lo, float hi) { const f32x2_t v = {lo, hi}; return __builtin_bit_cast(unsigned, __builtin_convertvector(v, bf16x2_t)); }
__device__ __forceinline__ int relane(int v) { asm volatile("" : "+v"(v)); return v; }
__device__ __forceinline__ void attn_init(AttnSt& st) {
#pragma unroll
    for (int d = 0; d < 4; ++d)
#pragma unroll
        for (int r = 0; r < 16; ++r) st.o[d][r] = 0.f;
    st.m = NEGF; st.l = 0.f;
}
template <int DQK> __device__ __forceinline__ void tile_offsets(unsigned (&off)[ACfg<DQK>::NI], unsigned krow, unsigned vrow, int wave, int lane) {
    using C = ACfg<DQK>;
#pragma unroll
    for (int j = 0; j < C::NI; ++j) { const int i = wave + 8 * j;
        if (i < C::KCH) { const int s = i * 64 + lane, r = s / C::KCH; int cc = s - r * C::KCH; cc = cc < DQK / 8 ? cc : 0; off[j] = (unsigned)r * krow * 2u + (unsigned)cc * 16u; }
        else { const int s = (i - C::KCH) * 64 + lane, r = (s / C::VCH) & 63; int cc = s % C::VCH; cc = cc < 16 ? cc : 0; off[j] = (unsigned)r * vrow * 2u + (unsigned)cc * 16u; } }
}
template <int DQK> __device__ __forceinline__ void tile_dma(LAS unsigned char* tb, const bf16* Kt, const bf16* Vt, const unsigned (&off)[ACfg<DQK>::NI], int wave) {
    using C = ACfg<DQK>;
#pragma unroll
    for (int j = 0; j < C::NI; ++j) { const int i = wave + 8 * j;
        if (i < C::KCH) __builtin_amdgcn_global_load_lds((const unsigned*)((const char*)Kt + off[j]), (LAS unsigned*)(tb + i * 1024), 16, 0, 0);
        else if (i < C::NDMA) __builtin_amdgcn_global_load_lds((const unsigned*)((const char*)Vt + off[j]), (LAS unsigned*)(tb + C::KBYTES + (i - C::KCH) * 1024), 16, 0, 0); }
}
#define DMA_WAIT_SYNC() do { asm volatile("s_waitcnt vmcnt(0)" ::: "memory"); __syncthreads(); } while (0)
template <int DQK> __device__ __forceinline__ void tile_scores(f32x16& s0, f32x16& s1, const bf16x8 (&qf)[DQK / 16], const LAS unsigned char* tb, const float c0  , int lane) {
    using C = ACfg<DQK>;
    const LAS unsigned char* kp = tb + (lane & 31) * C::KSTR + (lane >> 5) * 16;
#pragma unroll
    for (int r = 0; r < 16; ++r) { s0[r] = c0; s1[r] = c0; }
    bf16x8 kf[3][2];
    kf[0][0] = *(const LAS bf16x8*)(kp); kf[0][1] = *(const LAS bf16x8*)(kp + 32 * C::KSTR);
    kf[1][0] = *(const LAS bf16x8*)(kp + 32); kf[1][1] = *(const LAS bf16x8*)(kp + 32 * C::KSTR + 32);
    __builtin_amdgcn_sched_barrier(0);
#pragma unroll
    for (int st = 0; st < C::NSTEP; ++st) {
        if (st + 2 < C::NSTEP) { kf[(st + 2) % 3][0] = *(const LAS bf16x8*)(kp + (st + 2) * 32); kf[(st + 2) % 3][1] = *(const LAS bf16x8*)(kp + 32 * C::KSTR + (st + 2) * 32); }
        s0 = __builtin_amdgcn_mfma_f32_32x32x16_bf16(kf[st % 3][0], qf[st], s0, 0, 0, 0); s1 = __builtin_amdgcn_mfma_f32_32x32x16_bf16(kf[st % 3][1], qf[st], s1, 0, 0, 0);
        __builtin_amdgcn_sched_barrier(0); }
}
typedef float f32x2v __attribute__((ext_vector_type(2)));
__device__ __forceinline__ bf16x8 exp_pack8(const f32x16& s, int base, f32x2v& rs) {
    float e[8];
#pragma unroll
    for (int j = 0; j < 8; ++j) e[j] = __builtin_amdgcn_exp2f(s[base + j]);
#pragma unroll
    for (int j = 0; j < 4; ++j) rs += (f32x2v){e[2 * j], e[2 * j + 1]};
    u32x4 w; w.x = cvtpk(e[0], e[1]); w.y = cvtpk(e[2], e[3]); w.z = cvtpk(e[4], e[5]); w.w = cvtpk(e[6], e[7]);
    return __builtin_bit_cast(bf16x8, w);
}
template <int DQK> __device__ __forceinline__ void tile_compute(AttnSt& st, const bf16x8 (&qf)[DQK / 16], const LAS unsigned char* tb, int key0, int lo, int hi, int mode  , int lane) {
    using C = ACfg<DQK>; const int h = lane >> 5;
    const bool lane_off = (mode == 1) && (hi < 0);
    const bool fresh = (st.m == NEGF); const float ref = fresh ? 0.f : st.m;
    f32x16 s0, s1; tile_scores<DQK>(s0, s1, qf, tb, lane_off ? -3.0e38f : -ref, lane);
    float mx;
    if (mode == 2) {
#pragma unroll
        for (int r = 0; r < 16; ++r) { const int k0 = key0 + (r & 3) + 8 * (r >> 2) + 4 * h, k1 = k0 + 32;
            s0[r] = (k0 >= lo && k0 <= hi) ? s0[r] : NEGF; s1[r] = (k1 >= lo && k1 <= hi) ? s1[r] : NEGF; }
    }
    mx = fmaxf(s0[15], s1[15]);
#pragma unroll
    for (int r = 0; r < 15; ++r) asm("v_max3_f32 %0, %1, %2, %3" : "=v"(mx) : "v"(mx), "v"(s0[r]), "v"(s1[r]));
    mx = lane_off ? NEGF : mx;
    constexpr float RESCALE_THR = 8.0f;
    f32x2v rs = {0.f, 0.f};
    if (__builtin_amdgcn_ballot_w64(fresh ? (mx > 0.5f * NEGF) : (mx > RESCALE_THR)) != 0ull) {
        mx = xmax32(mx);
        const float mt = (mx > 0.5f * NEGF) ? mx + ref : NEGF, mn = fmaxf(st.m, mt), delta = (mn == NEGF || lane_off) ? 0.f : mn - ref;
        const float alpha = __builtin_amdgcn_exp2f(st.m - mn); st.l *= alpha;
#pragma unroll
        for (int d = 0; d < 4; ++d) st.o[d] = st.o[d] * alpha;
#pragma unroll
        for (int r = 0; r < 16; ++r) { s0[r] -= delta; s1[r] -= delta; }
        st.m = mn; }
    const LAS unsigned char* vp = tb + C::KBYTES + (4 * h + ((lane & 15) >> 2)) * C::VSTR + (((lane >> 4) & 1) * 16 + (lane & 3) * 4) * 2;
#define VFRAG(i) __builtin_shufflevector(vtr(vp + (16 * ((i) >> 2)) * C::VSTR + ((i) & 3) * 64), vtr(vp + (16 * ((i) >> 2) + 8) * C::VSTR + ((i) & 3) * 64), 0, 1, 2, 3, 4, 5, 6, 7)
    bf16x8 vf[4]; vf[0] = VFRAG(0); vf[1] = VFRAG(1); vf[2] = VFRAG(2);
    bf16x8 pb[2]; pb[0] = exp_pack8(s0, 0, rs);
    __builtin_amdgcn_sched_barrier(0);
#pragma unroll
    for (int ks = 0; ks < 4; ++ks) {
#pragma unroll
        for (int d = 0; d < 4; ++d) { const int i = 4 * ks + d;
            if (i + 3 < 16) vf[(i + 3) & 3] = VFRAG(i + 3);
            st.o[d] = __builtin_amdgcn_mfma_f32_32x32x16_bf16(vf[i & 3], pb[ks & 1], st.o[d], 0, 0, 0); }
#if MK_SENS == 1
        { const u32x4 zz = {0u, 0u, 0u, 0u}; const bf16x8 zf = __builtin_bit_cast(bf16x8, zz);
#pragma unroll
          for (int d = 0; d < 4; ++d) st.o[d] = __builtin_amdgcn_mfma_f32_32x32x16_bf16(vf[d], zf, st.o[d], 0, 0, 0); }
#endif
        __builtin_amdgcn_sched_barrier(0);
        if (ks < 3) { pb[(ks + 1) & 1] = exp_pack8(ks + 1 < 2 ? s0 : s1, 8 * ((ks + 1) & 1), rs); __builtin_amdgcn_sched_barrier(0); } }
#undef VFRAG
#if MK_SENS == 2
#pragma unroll
    for (int r = 0; r < 16; ++r) rs.x += __builtin_amdgcn_exp2f(s0[r] - 1000.f) + __builtin_amdgcn_exp2f(s1[r] - 1000.f);
#endif
    st.l += xsum32(rs.x + rs.y);
}
template <int DQK> __device__ __forceinline__ void attn_pass(AttnSt& st, const bf16x8 (&qf)[DQK / 16], LAS unsigned char* lds, const bf16* Kg, unsigned krow, const bf16* Vg, unsigned vrow,
                                                         unsigned tilemask, unsigned selbits, unsigned selall, int lo, int hi, int wlo, int whi, int ilo, int ihi, int tid, int lane) {
    using C = ACfg<DQK>;
    unsigned rem = (unsigned)__builtin_amdgcn_readfirstlane((int)tilemask); if (rem == 0u) return;
    int kt = __builtin_ctz(rem); rem &= rem - 1u;
    unsigned off[C::NI]; const int wave = __builtin_amdgcn_readfirstlane(tid >> 6); tile_offsets<DQK>(off, krow, vrow, wave, lane);
    tile_dma<DQK>(lds, Kg + (size_t)kt * 64 * krow, Vg + (size_t)kt * 64 * vrow, off, wave);
    DMA_WAIT_SYNC();
    int buf = 0;
    for (;;) {
        const bool more = rem != 0u; int ktn = 0;
        if (more) { ktn = __builtin_ctz(rem); rem &= rem - 1u; tile_dma<DQK>(lds + (buf ^ 1) * C::STAGE, Kg + (size_t)ktn * 64 * krow, Vg + (size_t)ktn * 64 * vrow, off, wave); }
        if (kt * 64 <= whi && kt * 64 + 63 >= wlo) tile_compute<DQK>(st, qf, lds + buf * C::STAGE, kt * 64, lo, ((selbits >> kt) & 1u) ? hi : -1, (kt * 64 >= ilo && kt * 64 + 63 <= ihi) ? (((selall >> kt) & 1u) ? 0 : 1) : 2, lane);
        DMA_WAIT_SYNC();
        if (!more) break;
        kt = ktn; buf ^= 1;
    }
}

__device__ __forceinline__ float sumsq8(const u32x4 w) { float v[8]; unpack8(w, v); return ((v[0] * v[0] + v[1] * v[1]) + (v[2] * v[2] + v[3] * v[3])) + ((v[4] * v[4] + v[5] * v[5]) + (v[6] * v[6] + v[7] * v[7])); }
__device__ __forceinline__ void scaled8(float (&v)[8], const u32x4 w, float r, const float* g) { unpack8(w, v); const f32x4 ga = *(const f32x4*)g, gb = *(const f32x4*)(g + 4);
#pragma unroll
    for (int j = 0; j < 8; ++j) v[j] *= r * (j < 4 ? ga[j & 3] : gb[j & 3]); }
__device__ __forceinline__ void rope8(float (&x1)[8], float (&x2)[8], const float* cs_p, const float* sn_p) { const f32x4 ca = *(const f32x4*)cs_p, cb = *(const f32x4*)(cs_p + 4), sa = *(const f32x4*)sn_p, sb = *(const f32x4*)(sn_p + 4);
#pragma unroll
    for (int j = 0; j < 8; ++j) { const float cs = j < 4 ? ca[j & 3] : cb[j & 3], sn = j < 4 ? sa[j & 3] : sb[j & 3], a = x1[j], b2 = x2[j]; x1[j] = a * cs - b2 * sn; x2[j] = b2 * cs + a * sn; } }
__device__ __forceinline__ bf16x8 packs8(float (&v)[8], float sc) {
#pragma unroll
    for (int j = 0; j < 8; ++j) v[j] *= sc;
    return __builtin_bit_cast(bf16x8, pack8(v)); }
__device__ __forceinline__ void mla_load_q(bf16x8 (&qf)[12], const bf16* qrow, const float* gq, const float* tabA_row, int h, int lane) {
    u32x4 w[12]; float ss = 0.f;
#pragma unroll
    for (int s = 0; s < 12; ++s) { w[s] = *(const u32x4*)(qrow + 16 * s + 8 * h); ss += sumsq8(w[s]); }
    ss += shx(ss, 32, lane); const float r = __builtin_amdgcn_rsqf(ss * (1.0f / 192.0f) + EPS);
#pragma unroll
    for (int s = 0; s < 8; ++s) { float v[8]; scaled8(v, w[s], r, gq + 16 * s + 8 * h); qf[s] = packs8(v, QS_MLA); }
#pragma unroll
    for (int s = 8; s < 10; ++s) { float x1[8], x2[8]; scaled8(x1, w[s], r, gq + 16 * s + 8 * h); scaled8(x2, w[s + 2], r, gq + 16 * (s + 2) + 8 * h);
        const int i0 = 16 * (s - 8) + 8 * h; rope8(x1, x2, tabA_row + i0, tabA_row + T * 32 + i0); qf[s] = packs8(x1, QS_MLA); qf[s + 2] = packs8(x2, QS_MLA); }
}
template <bool ROPE> __device__ __forceinline__ void nsa_load_q(bf16x8 (&qf)[8], const bf16* qrow, const float* gq, const float* tabB_row, int h, int lane) {
    u32x4 w[8]; float ss = 0.f;
#pragma unroll
    for (int s = 0; s < 8; ++s) { w[s] = *(const u32x4*)(qrow + 16 * s + 8 * h); ss += sumsq8(w[s]); }
    ss += shx(ss, 32, lane); const float r = __builtin_amdgcn_rsqf(ss * (1.0f / 128.0f) + EPS);
#pragma unroll
    for (int s = 0; s < 4; ++s) { float x1[8], x2[8]; scaled8(x1, w[s], r, gq + 16 * s + 8 * h); scaled8(x2, w[s + 4], r, gq + 16 * (s + 4) + 8 * h);
        if (ROPE) { const int i0 = 16 * s + 8 * h; rope8(x1, x2, tabB_row + i0, tabB_row + T * 64 + i0); }
        qf[s] = packs8(x1, QS_NSA); qf[s + 4] = packs8(x2, QS_NSA); }
}

template <bool RMW> __device__ __forceinline__ void attn_out16(const AttnSt& st, float sc, bf16* rowp  , int h) {
#pragma unroll
    for (int d = 0; d < 4; ++d)
#pragma unroll
        for (int k = 0; k < 2; ++k) { float e[4], o[4];
#pragma unroll
            for (int i = 0; i < 4; ++i) { e[i] = st.o[d][8 * k + i] * sc; o[i] = st.o[d][8 * k + 4 + i] * sc; asm volatile("s_nop 1\n\tv_permlane32_swap_b32 %0, %1" : "+v"(e[i]), "+v"(o[i])); }
            bf16* p = rowp + 32 * d + 8 * (2 * k + h);
            if (RMW) { float v[8]; unpack8(*(const u32x4*)p, v);
#pragma unroll
                for (int i = 0; i < 4; ++i) { e[i] += v[i]; o[i] += v[4 + i]; } }
            u32x4 w; w.x = cvt_pk_bf16(e[0], e[1]); w.y = cvt_pk_bf16(e[2], e[3]); w.z = cvt_pk_bf16(o[0], o[1]); w.w = cvt_pk_bf16(o[2], o[3]);
            *(u32x4*)p = w; }
}

__device__ __forceinline__ void mla_attn_unit(int b, int hd, int qb, const bf16* Qraw, const float* gq, const float* tabA, const bf16* Kf, const bf16* KVraw, bf16* OB, LAS unsigned char* lds, int tid, int lane, int wave) {
    const int r32 = lane & 31, h = lane >> 5, q = qb * 256 + wave * 32 + r32; const size_t tok = (size_t)b * SEQ + q;
    bf16x8 qf[12]; mla_load_q(qf, Qraw + tok * 6144 + hd * 192, gq, tabA + tok * 32, h, lane);
    AttnSt st; attn_init(st);
    const int ntiles = 4 * qb + 4; const unsigned tilemask = ntiles >= 32 ? 0xffffffffu : ((1u << ntiles) - 1u);
    attn_pass<192>(st, qf, lds, Kf + ((size_t)b * SEQ * 32 + hd) * 192, 32u * 192u, KVraw + (size_t)b * SEQ * 8192 + hd * 256 + 128, 8192u,
                   tilemask, 0xffffffffu, 0xffffffffu, 0, q, 0, qb * 256 + wave * 32 + 31, 0, qb * 256 + wave * 32, tid, lane);
    const int l2 = relane(lane); const size_t tok2 = (size_t)b * SEQ + qb * 256 + wave * 32 + (l2 & 31);
    attn_out16<false>(st, 1.0f / st.l, OB + tok2 * DM + hd * 128, l2 >> 5);
}

__device__ __forceinline__ f32x4 ld4bf(const bf16* p) { const u32x2 w = *(const u32x2*)p; return (f32x4){__builtin_bit_cast(float, w.x << 16), __builtin_bit_cast(float, w.x & 0xffff0000u), __builtin_bit_cast(float, w.y << 16), __builtin_bit_cast(float, w.y & 0xffff0000u)}; }
__device__ __forceinline__ void st4bf(bf16* p, float a, float b, float c, float d) { u32x2 w; w.x = cvt_pk_bf16(a, b); w.y = cvt_pk_bf16(c, d); *(u32x2*)p = w; }
constexpr int IMP_OFF = 2 * ACfg<128>::STAGE, IMP_SLICE = 32 * 33 * 4, IMP2_OFF = IMP_OFF + NWAVES * IMP_SLICE;
static_assert(IMP2_OFF + 32 * 36 * 4 <= RING_BYTES && 2 * ACfg<192>::STAGE <= RING_BYTES, "attention LDS");
__device__ __forceinline__ void nsa_cmp_unit(int b, int g, int tt, const bf16* Qraw, const float* gq, const bf16* Kc, const bf16* Vc, const float* GP, const float* bgate, float* gates, bf16* oacc, unsigned* SEL, LAS unsigned char* lds, int tid, int lane, int wave) {
    const int r32 = lane & 31, h = lane >> 5, t0 = tt * 32, t = t0 + r32, head = g * 8 + wave; const size_t tok = (size_t)b * SEQ + t;
    bf16x8 qf[8]; nsa_load_q<false>(qf, Qraw + tok * 4096 + head * 128, gq, nullptr, h, lane);
    const int nvalid = t >= 31 ? ((t - 31) >> 4) + 1 : 0;
    AttnSt st; attn_init(st);
    const bf16* Kg = Kc + (size_t)(b * 4 + g) * 128 * 128; const bf16* Vg = Vc + (size_t)(b * 4 + g) * 128 * 128;
    LAS float* imp = (LAS float*)(lds + IMP_OFF + wave * IMP_SLICE); LAS float* imp2 = (LAS float*)(lds + IMP2_OFF);
    attn_pass<128>(st, qf, lds, Kg, 128u, Vg, 128u, 3u, 0xffffffffu, 0xffffffffu, 0, nvalid - 1, 0, t0 >> 4, 0, (t0 >= 31 ? ((t0 - 31) >> 4) : -1), tid, lane);
    const float invl = nvalid > 0 ? 1.0f / st.l : 0.f;
    { const int l2 = relane(lane); const size_t tok2 = (size_t)b * SEQ + t0 + (l2 & 31);
      float g3[3];
      { struct F3 { float x, y, z; }; float s0g = bgate[head * 3], s1g = bgate[head * 3 + 1], s2g = bgate[head * 3 + 2];
#pragma unroll
        for (int ks = 0; ks < 8; ++ks) { const F3 v = *(const F3*)(GP + ((size_t)ks * T + tok2) * 96 + head * 3); s0g += v.x; s1g += v.y; s2g += v.z; }
        g3[0] = pg8::sigmoid_f(s0g); g3[1] = pg8::sigmoid_f(s1g); g3[2] = pg8::sigmoid_f(s2g); }
      if ((l2 >> 5) == 0) { gates[tok2 * 96 + head * 3 + 0] = g3[0]; gates[tok2 * 96 + head * 3 + 1] = g3[1]; gates[tok2 * 96 + head * 3 + 2] = g3[2]; }
      attn_out16<false>(st, invl * g3[0], oacc + tok2 * 4096 + head * 128, l2 >> 5); }
    { float Bv[16];
#pragma unroll
      for (int tl = 0; tl < 2; ++tl) { f32x16 s0, s1; tile_scores<128>(s0, s1, qf, lds + tl * ACfg<128>::STAGE, 0.f, lane);
#pragma unroll
          for (int kb = 0; kb < 2; ++kb)
#pragma unroll
              for (int gq = 0; gq < 4; ++gq) { float P[4];
#pragma unroll
                  for (int i = 0; i < 4; ++i) { const int n = 64 * tl + 32 * kb + 8 * gq + 4 * h + i; const float sv = kb ? s1[4 * gq + i] : s0[4 * gq + i]; P[i] = (n < nvalid) ? __builtin_amdgcn_exp2f(sv - st.m) * invl : 0.f; }
                  const int jp = 16 * tl + 8 * kb + 2 * gq + h;
                  imp[r32 * 33 + jp] = 2.0f * (P[0] + P[1] + P[2]) + P[3]; Bv[tl * 8 + kb * 4 + gq] = P[3]; } }
      LDS_WAIT(); asm volatile("" ::: "memory");
#pragma unroll
      for (int tl = 0; tl < 2; ++tl)
#pragma unroll
          for (int kb = 0; kb < 2; ++kb)
#pragma unroll
              for (int gq = 0; gq < 4; ++gq) { const int jp = 16 * tl + 8 * kb + 2 * gq + h; imp[r32 * 33 + jp + 1] += Bv[tl * 8 + kb * 4 + gq]; } }
    __syncthreads();
    { const int tl = tid >> 4, jj = (tid & 15) * 2, tq = t0 + tl, cur = tq >> 6; float mine[2]; bool valid[2];
#pragma unroll
      for (int e = 0; e < 2; ++e) { const int j = jj + e; const bool forced = (j == 0) || (j == cur) || (j == cur - 1); valid[e] = j <= cur;
          float sum = 0.f;
#pragma unroll
          for (int w = 0; w < NWAVES; ++w) sum += ((const LAS float*)(lds + IMP_OFF + w * IMP_SLICE))[tl * 33 + j];
          mine[e] = forced ? 1e6f : (valid[e] ? sum : -1.0f); imp2[tl * 36 + j] = mine[e]; }
      __syncthreads();
      unsigned bits = 0u;
      int cnt0 = 0, cnt1 = 0;
#pragma unroll
      for (int i4 = 0; i4 < 8; ++i4) { const f32x4 xv = *(const LAS f32x4*)(imp2 + tl * 36 + 4 * i4);
#pragma unroll
          for (int q = 0; q < 4; ++q) { const int i = 4 * i4 + q; const float x = xv[q];
              cnt0 += (x > mine[0] || (x == mine[0] && i < jj)) ? 1 : 0; cnt1 += (x > mine[1] || (x == mine[1] && i < jj + 1)) ? 1 : 0; } }
      if (cnt0 < 16 && valid[0]) bits |= 1u << jj;
      if (cnt1 < 16 && valid[1]) bits |= 1u << (jj + 1);
      bits |= shxu(bits, 1, lane); bits |= shxu(bits, 2, lane); bits |= shxu(bits, 4, lane); bits |= shxu(bits, 8, lane);
      if ((tid & 15) == 0) SEL[(size_t)(b * 4 + g) * SEQ + tq] = bits;
      __syncthreads(); }
}

__device__ __forceinline__ void nsa_sw_unit(int b, int g, int tt, const bf16* Qraw, const float* gq, const float* tabB, const bf16* Ks, const bf16* Vs, const bf16* Kw, const bf16* Vw, const float* gates, const unsigned* SEL, bf16* OB,
                                            LAS unsigned char* lds, int tid, int lane, int wave) {
    const int r32 = lane & 31, h = lane >> 5, t0 = tt * 32, t = t0 + r32, head = g * 8 + wave; const size_t tok = (size_t)b * SEQ + t;
    bf16x8 qf[8]; nsa_load_q<true>(qf, Qraw + tok * 4096 + head * 128, gq, tabB + tok * 64, h, lane);
    const unsigned sel = SEL[(size_t)(b * 4 + g) * SEQ + t]; unsigned uni = sel, all = sel;
#pragma unroll
    for (int o = 1; o < 64; o <<= 1) { uni |= shxu(uni, o, lane); all &= shxu(all, o, lane); }
    all = (unsigned)__builtin_amdgcn_readfirstlane((int)all);
    const int cur = t0 >> 6; const unsigned causal_tiles = cur >= 31 ? 0xffffffffu : ((2u << cur) - 1u);
    const size_t kvoff = (size_t)b * SEQ * 512 + g * 128;
    AttnSt st; attn_init(st);
    attn_pass<128>(st, qf, lds, Ks + kvoff, 512u, Vs + kvoff, 512u, uni & causal_tiles, sel, all, 0, t, 0, t0 + 31, 0, t0, tid, lane);
    { const int l2 = relane(lane); const size_t tok2 = (size_t)b * SEQ + t0 + (l2 & 31);
      attn_out16<true>(st, gates[tok2 * 96 + head * 3 + 1] / st.l, OB + tok2 * DM + head * 128, l2 >> 5); }
    attn_init(st);
    const int wlo = t0 - 511 > 0 ? t0 - 511 : 0, whi = t0 + 31, ktl = wlo >> 6, kth = whi >> 6;
    const unsigned wmask = (kth >= 31 ? 0xffffffffu : ((2u << kth) - 1u)) & ~((1u << ktl) - 1u);
    attn_pass<128>(st, qf, lds, Kw + kvoff, 512u, Vw + kvoff, 512u, wmask, 0xffffffffu, 0xffffffffu, t - 511 > 0 ? t - 511 : 0, t, wlo, whi, (t0 + 31 - 511 > 0 ? t0 + 31 - 511 : 0), t0, tid, lane);
    { const int l2 = relane(lane); const size_t tok2 = (size_t)b * SEQ + t0 + (l2 & 31);
      attn_out16<true>(st, gates[tok2 * 96 + head * 3 + 2] / st.l, OB + tok2 * DM + head * 128, l2 >> 5); }
}
constexpr int N_PHASES = 1 + 2 * 9 + 2 * 8 + 3;
#ifndef MK_MULTI
#define MK_MULTI 0
#endif
__device__ __forceinline__ int lane_id_asm() { int l; asm volatile("v_mbcnt_lo_u32_b32 %0, -1, 0\n\tv_mbcnt_hi_u32_b32 %0, -1, %0" : "=v"(l)); return l; }
__device__ __forceinline__ int opq_v(int v) { asm volatile("" : "+v"(v)); return v; }
__device__ __forceinline__ int opq_s(int v) { asm volatile("" : "+s"(v)); return v; }
#define CAS __attribute__((address_space(4)))
typedef const CAS Args* ArgsP;
__device__ __forceinline__ ArgsP opq_args() { ArgsP p = (ArgsP)__builtin_amdgcn_kernarg_segment_ptr(); asm volatile("" : "+s"(p)); return p; }
__global__ void __launch_bounds__(NTHREADS, 2) trunk_fwd(Args args_k) {
    extern __shared__ __attribute__((aligned(16))) unsigned char lds_raw[];
    LAS unsigned char* lds = (LAS unsigned char*)lds_raw;
    volatile LAS unsigned* MISC = (volatile LAS unsigned*)(lds + MISC_OFF);
    for (int u = threadIdx.x; u < (LDS_BYTES - LDSCTL_OFF) / 4; u += NTHREADS) ((LAS unsigned*)(lds + LDSCTL_OFF))[u] = 0u;
    __syncthreads();
    const int lo = args_k.ph_lo, hi = args_k.ph_hi, wave_k = __builtin_amdgcn_readfirstlane((int)threadIdx.x >> 6);
    XcdBarrier bar; bar.bar = (unsigned*)(args_k.ws + WS_CTL) + CW_BAR; bar.x = 0; bar.st = nullptr;
    if (hi - lo > 1) bar = xcd_barrier_post((unsigned*)(args_k.ws + WS_CTL) + CW_BAR, MISC + 8);
#ifndef MK_PROBE
#define MK_PROBE 0
#endif
#define REP(k) for (int rep_ = 0; rep_ < ((MK_PROBE == (k)) ? 2 : 1); ++rep_)
    int ph = 0, layer_i = 0, sub_i = 0;
#define PH_BEGIN if (ph >= lo && ph < hi) { asm volatile("; PHMARK %0" :: "i"(__LINE__)); const CAS Args& args = *opq_args(); const int layer = opq_s(layer_i), sub = opq_s(sub_i); (void)layer; (void)sub; const int wave = opq_s(wave_k), lane = lane_id_asm(), tid = wave * 64 + lane; \
    const int G = opq_s((int)gridDim.x), bx = opq_s((int)blockIdx.x), vcu = (G % 8 == 0) ? (bx % 8) * (G / 8) + bx / 8 : bx, gw = vcu * NWAVES + wave, NGW = G * NWAVES; (void)lane; (void)gw; (void)NGW; (void)vcu; unsigned char* ws = args.ws; float* ssb = (float*)(ws + SS_OFF); constexpr size_t SSL = (size_t)T * 64; \
    bf16* HB = (bf16*)(ws + WS_HB); bf16* ACT = (bf16*)(ws + WS_ACT); bf16* CBUF = (bf16*)(ws + WS_CBUF); bf16* QRAW = (bf16*)(ws + WS_QRAW); bf16* KVRAW = (bf16*)(ws + WS_KVRAW); \
    bf16* QF = (bf16*)(ws + WS_QF); bf16* KF = (bf16*)(ws + WS_KF); bf16* OB = (bf16*)(ws + WS_OB); float* GATES = (float*)(ws + WS_GATES); unsigned* SEL = (unsigned*)(ws + WS_SEL); \
    float* OACC = (float*)(ws + WS_KVRAW); float* KVS = (float*)(ws + WS_KVS); (void)ssb; (void)HB; (void)ACT; (void)CBUF; (void)QRAW; (void)KVRAW; (void)QF; (void)KF; (void)OB; (void)GATES; (void)SEL; (void)OACC; (void)KVS;
#ifndef MK_BAR2
#define MK_BAR2 0
#endif
#define PH_END if (ph + 1 < hi) { xcd_barrier(bar); if (MK_BAR2) xcd_barrier(bar); } } ++ph;
#define RS_FILL(ssptr, nparts_, invdim_, M_, N_, cidx) pg8::RsTab rt_; { pg8::StaticOrder S0_; S0_.init((M_), (N_), G, (cidx)); pg8::Unit u0_; rt_.tab = (const LAS float*)(lds + RSTAB_OFF); rt_.pm = -1; \
        if (S0_.next(0, u0_)) { rt_.pm = u0_.pm; pg8::rs_table_fill((LAS float*)(lds + RSTAB_OFF), (ssptr), (nparts_), (invdim_), u0_.pm, tid, lane); } }
#define RUN_GEMM(EPI_T, E, Aptr, lda_, Bptr, M_, N_, K_, cidx) do { const pg8::Gemm g_{(const pg8::bf16_t*)(Aptr), (const pg8::bf16_t*)(Bptr), (M_), (N_), (K_), (lda_)}; pg8::StaticOrder S_; S_.init((M_), (N_), G, (cidx)); \
        pg8::gemm_phase<EPI_T, pg8::StaticOrder, EPI_T::ALIGN, true>(lds, g_, S_, (E), opq_v(tid)); } while (0)

    REP(1) {
    PH_BEGIN prologue(args, lds, vcu, G, wave, lane, tid); PH_END
    }

    for (layer_i = 0; layer_i < DEPTH; ++layer_i) {
        for (sub_i = 0; sub_i < 3; ++sub_i) {
            if (sub_i != 1) {
                REP(2) {
                PH_BEGIN { const int which = sub >> 1; unsigned char* wgu = ws + WS_FFN + (size_t)(layer * 2 + which) * FFN_B; const float* ssp = ssb + (size_t)(3 * layer + sub) * SSL; const int np = (layer == 0 && sub == 0) ? 1 : 64; RS_FILL(ssp, np, 1.0f / DM, T, 2 * FF, bx)
                    const pg8::EpiSwiGLU E{ACT, FF, ssp, np, 1.0f / DM, rt_}; RUN_GEMM(pg8::EpiSwiGLU, E, HB, DM, wgu, T, 2 * FF, DM, bx);
                    if (layer == 2 && sub == 0) { nsa_cmp_out(args, lds, gw, NGW, wave, lane); __syncthreads(); }
                    cvt_range(args, 6 * layer + 3 * which + 2, 1, lds, gw, NGW, wave, lane); } PH_END
                }
                PH_BEGIN { const int which = sub >> 1; unsigned char* wgu = ws + WS_FFN + (size_t)(layer * 2 + which) * FFN_B; const bool last = (layer == DEPTH - 1 && sub == 2), first = (layer == 0 && sub == 0);
                    const pg8::EpiResid E{first ? (const float*)args.in[I_X] : nullptr, HB, last ? args.out : nullptr, last ? nullptr : ssb + (size_t)(3 * layer + sub + 1) * SSL, 0.5f, DM}; RUN_GEMM(pg8::EpiResid, E, ACT, FF, wgu + FFN_GU_B, T, DM, FF, bx);
                    if (sub == 0) cvt_range(args, layer < 2 ? 24 + 4 * layer : 32 + 3 * (layer - 2), layer < 2 ? 1 : 2, lds, gw, NGW, wave, lane);
                    else if (layer < DEPTH - 1) { if (layer == 1) cvt_range(args, 38, 4, lds, gw, NGW, wave, lane); else cvt_range(args, 6 * (layer + 1), 2, lds, gw, NGW, wave, lane); } } PH_END
#if MK_PROBE == 7
                PH_BEGIN { const int which = sub >> 1; unsigned char* wgu = ws + WS_FFN + (size_t)(layer * 2 + which) * FFN_B;
                    const pg8::EpiResid E{(const float*)args.in[I_X], (pg8::bf16_t*)(ws + WS_QF), nullptr, nullptr, 0.5f, DM}; RUN_GEMM(pg8::EpiResid, E, ACT, FF, wgu + FFN_GU_B, T, DM, FF, bx); } PH_END
#endif
            } else if (layer_i < 2) {
#define MLA_PTRS unsigned char* wm = ws + WS_MLA + (size_t)layer * MLA_B; float* sscq = ssb + (size_t)(SS_CQ + layer) * SSL; float* ssckv = ssb + (size_t)(SS_CKV + layer) * SSL; (void)wm; (void)sscq; (void)ssckv;
                REP(5) {
                PH_BEGIN { MLA_PTRS RS_FILL(ssb + (size_t)(3 * layer + 1) * SSL, 64, 1.0f / DM, T, MLA_IN_P, bx) const pg8::EpiScaleBf16 E{CBUF, MLA_IN_P, ssb + (size_t)(3 * layer + 1) * SSL, 64, 1.0f / DM, sscq, ssckv, 4, 6, rt_}; RUN_GEMM(pg8::EpiScaleBf16, E, HB, DM, wm, T, MLA_IN_P, DM, bx);
                           constexpr int NU_ = (T / 256) * (MLA_IN_P / 256);
                           if (G > NU_) { if (bx >= NU_) cvt_range(args, 25 + 4 * layer, 2, lds, (bx - NU_) * NWAVES + wave, (G - NU_) * NWAVES, wave, lane); } else cvt_range(args, 25 + 4 * layer, 2, lds, gw, NGW, wave, lane); } PH_END
                PH_BEGIN { MLA_PTRS { RS_FILL(sscq, 16, 1.0f / QLORA, T, 6144, bx) const pg8::EpiScaleBf16 E1{QRAW, 6144, sscq, 16, 1.0f / QLORA, nullptr, nullptr, 0, 0, rt_}; RUN_GEMM(pg8::EpiScaleBf16, E1, CBUF, MLA_IN_P, wm + MLA_WIN_B, T, 6144, QLORA, bx); }
                           RS_FILL(ssckv, 8, 1.0f / KVLORA, T, 8192, bx) const pg8::EpiScaleBf16 E2{KVRAW, 8192, ssckv, 8, 1.0f / KVLORA, nullptr, nullptr, 0, 0, rt_}; RUN_GEMM(pg8::EpiScaleBf16, E2, CBUF + QLORA, MLA_IN_P, wm + MLA_WIN_B + MLA_WUQ_B, T, 8192, KVLORA, bx); } PH_END
                }
                REP(3) {
                PH_BEGIN mla_k_finalize(KVRAW, CBUF, (const float*)args.in[I_MGK] + layer * MLA_QK, (const float*)(ws + WS_TABA), KF, gw, NGW, lane); PH_END
                PH_BEGIN for (int u = vcu; u < 512; u += G) { const int bh = u >> 2, pi = u & 3;
                             const float* gq = (const float*)args.in[I_MGQ] + layer * MLA_QK; const float* tabA = (const float*)(ws + WS_TABA);
                             mla_attn_unit(bh >> 5, bh & 31, 7 - pi, QRAW, gq, tabA, KF, KVRAW, OB, lds, tid, lane, wave); mla_attn_unit(bh >> 5, bh & 31, pi, QRAW, gq, tabA, KF, KVRAW, OB, lds, tid, lane, wave); }
                         __syncthreads(); cvt_range(args, 27 + 4 * layer, 1, lds, gw, NGW, wave, lane); PH_END
                }
                PH_BEGIN { MLA_PTRS const pg8::EpiResid E{nullptr, HB, nullptr, ssb + (size_t)(3 * layer + 2) * SSL, 1.0f, DM}; RUN_GEMM(pg8::EpiResid, E, OB, DM, wm + MLA_WIN_B + MLA_WUQ_B + MLA_WUKV_B, T, DM, DM, bx); cvt_range(args, 6 * layer + 3, 2, lds, gw, NGW, wave, lane); } PH_END
#if MK_PROBE == 9
                PH_BEGIN { MLA_PTRS const pg8::EpiResid E{(const float*)args.in[I_X], (pg8::bf16_t*)(ws + WS_QF), nullptr, nullptr, 1.0f, DM}; RUN_GEMM(pg8::EpiResid, E, OB, DM, wm + MLA_WIN_B + MLA_WUQ_B + MLA_WUKV_B, T, DM, DM, bx); } PH_END
#endif
            } else {
#define NSA_PTRS const int bl = layer - 2; unsigned char* wn = ws + WS_NSA + (size_t)bl * NSA_B;
                REP(8) PH_BEGIN { NSA_PTRS const float* ssm = ssb + (size_t)(3 * layer + 1) * SSL;
                    { RS_FILL(ssm, 64, 1.0f / DM, T, 4096, bx) const pg8::EpiScaleBf16 E{QRAW, 4096, ssm, 64, 1.0f / DM, nullptr, nullptr, 0, 0, rt_}; RUN_GEMM(pg8::EpiScaleBf16, E, HB, DM, wn, T, 4096, DM, bx); }
                    for (int uid = bx; uid < 256; uid += G) { const int ks = uid >> 5, c2 = uid & 31; RS_FILL(ssm, 64, 1.0f / DM, T, 256, c2)
                        const pg8::EpiGateP E2{(float*)(ws + WS_GP) + (size_t)ks * T * 96, ssm, 64, 1.0f / DM, rt_};
                        const pg8::Gemm g2{(const pg8::bf16_t*)(HB + ks * 512), (const pg8::bf16_t*)(wn + NSA_WQ_B + (size_t)ks * GSL_B), T, 256, 512, DM}; pg8::StaticOrder S2; S2.init(T, 256, 32, c2);
                        pg8::gemm_phase<pg8::EpiGateP, pg8::StaticOrder, true, true>(lds, g2, S2, E2, opq_v(tid)); } } PH_END
                REP(4) {
                PH_BEGIN for (int u = vcu; u < 512; u += G) { const int bg = u >> 5, pi = u & 31;
                             nsa_cmp_unit(bg >> 2, bg & 3, 63 - pi, QRAW, (const float*)args.in[I_NGQ] + (layer - 2) * DH, (const bf16*)(ws + WS_KC), (const bf16*)(ws + WS_VC), (const float*)(ws + WS_GP), (const float*)args.in[I_NBG] + (layer - 2) * 96, GATES, OB, SEL, lds, tid, lane, wave);
                             nsa_cmp_unit(bg >> 2, bg & 3, pi, QRAW, (const float*)args.in[I_NGQ] + (layer - 2) * DH, (const bf16*)(ws + WS_KC), (const bf16*)(ws + WS_VC), (const float*)(ws + WS_GP), (const float*)args.in[I_NBG] + (layer - 2) * 96, GATES, OB, SEL, lds, tid, lane, wave); } PH_END
                PH_BEGIN for (int u = vcu; u < 512; u += G) { const int bg = u >> 5, pi = u & 31;
                             nsa_sw_unit(bg >> 2, bg & 3, 63 - pi, QRAW, (const float*)args.in[I_NGQ] + (layer - 2) * DH, (const float*)(ws + WS_TABB), (const bf16*)(ws + WS_KSLC), (const bf16*)(ws + WS_VSLC), (const bf16*)(ws + WS_KWIN), (const bf16*)(ws + WS_VWIN), GATES, SEL, OB, lds, tid, lane, wave);
                             nsa_sw_unit(bg >> 2, bg & 3, pi, QRAW, (const float*)args.in[I_NGQ] + (layer - 2) * DH, (const float*)(ws + WS_TABB), (const bf16*)(ws + WS_KSLC), (const bf16*)(ws + WS_VSLC), (const bf16*)(ws + WS_KWIN), (const bf16*)(ws + WS_VWIN), GATES, SEL, OB, lds, tid, lane, wave); }
                         __syncthreads(); cvt_range(args, 34 + 3 * (layer - 2), 1, lds, gw, NGW, wave, lane); PH_END
                }
                PH_BEGIN { NSA_PTRS const pg8::EpiResid E{nullptr, HB, nullptr, ssb + (size_t)(3 * layer + 2) * SSL, 1.0f, DM}; RUN_GEMM(pg8::EpiResid, E, OB, DM, wn + NSA_WIN_B, T, DM, DM, bx); cvt_range(args, 6 * layer + 3, 2, lds, gw, NGW, wave, lane); } PH_END
#if MK_PROBE == 9
                PH_BEGIN { NSA_PTRS const pg8::EpiResid E{(const float*)args.in[I_X], (pg8::bf16_t*)(ws + WS_QF), nullptr, nullptr, 1.0f, DM}; RUN_GEMM(pg8::EpiResid, E, OB, DM, wn + NSA_WIN_B, T, DM, DM, bx); } PH_END
#endif
            }
        }
        if (layer_i == 1) {
            REP(6) {
            PH_BEGIN { const float* ss6 = ssb + (size_t)6 * SSL;
                { RS_FILL(ss6, 64, 1.0f / DM, T, 2048, bx) const pg8::EpiScaleF32 E{KVS, NKV, ss6, 64, 1.0f / DM, rt_}; RUN_GEMM(pg8::EpiScaleF32, E, HB, DM, ws + WS_KVW, T, 2048, DM, bx); }
                for (int uid = bx; uid < 256; uid += G) { const int ks = uid >> 7, c2 = uid & 127; RS_FILL(ss6, 64, 1.0f / DM, T, 1024, c2)
                    const pg8::EpiScaleF32 E2{(float*)(ws + WS_ACT) + (size_t)ks * T * 1024, 1024, ss6, 64, 1.0f / DM, rt_};
                    const pg8::Gemm g2{(const pg8::bf16_t*)(HB + ks * 2048), (const pg8::bf16_t*)(ws + WS_KVW + (size_t)2048 * DM * 2) + (size_t)ks * 1024 * 2048, T, 1024, 2048, DM}; pg8::StaticOrder S2; S2.init(T, 1024, 128, c2);
                    pg8::gemm_phase<pg8::EpiScaleF32, pg8::StaticOrder, true, true>(lds, g2, S2, E2, opq_v(tid)); } } PH_END
            PH_BEGIN nsa_kv_finalize(args, gw, NGW, lane); PH_END
            PH_BEGIN {
                for (int uid = bx; uid < 128; uid += G) { const int mat = uid >> 6, ks = (uid >> 3) & 7, c2 = uid & 7;
                    const pg8::EpiPartF32 E{(float*)(ws + WS_KVS) + (size_t)(mat * 8 + ks) * CMP_ROWS_P * 256, 256};
                    const pg8::Gemm g2{(const pg8::bf16_t*)(ws + (mat ? WS_BLKV : WS_BLKK)) + ks * 512, (const pg8::bf16_t*)(ws + WS_CW1 + (size_t)mat * CW1_B + (size_t)ks * GSL_B), CMP_ROWS_P, 256, 512, 4096};
                    pg8::StaticOrder S2; S2.init(CMP_ROWS_P, 256, 8, c2); pg8::gemm_phase<pg8::EpiPartF32, pg8::StaticOrder, true, true>(lds, g2, S2, E, opq_v(tid)); }
                cvt_range(args, 12, 2, lds, gw, NGW, wave, lane); } PH_END
            }
        }
    }
#undef PH_BEGIN
#undef PH_END
#undef RUN_GEMM
}

extern "C" void kernel_launch(void* const* d_in, const int* in_sizes, int n_in, void* d_out, int out_size, void* d_ws, size_t ws_size, hipStream_t stream) {
    static int grid = 0;
    if (grid == 0) {
        if (n_in != 36 || in_sizes[0] != T * DM || out_size != T * DM || ws_size < WS_END) { fprintf(stderr, "kernel_launch: unexpected problem (n_in %d, in0 %d, out %d, ws %zu < %zu); nothing launched\n", n_in, n_in > 0 ? in_sizes[0] : -1, out_size, ws_size, (size_t)WS_END); grid = -1; return; }
        int dev = 0, cus = 0, per_cu = 0;
        if (hipGetDevice(&dev) != hipSuccess || hipDeviceGetAttribute(&cus, hipDeviceAttributeMultiprocessorCount, dev) != hipSuccess) { fprintf(stderr, "kernel_launch: device query failed\n"); grid = -1; return; }
        if (hipFuncSetAttribute((const void*)trunk_fwd, hipFuncAttributeMaxDynamicSharedMemorySize, LDS_BYTES) != hipSuccess) { fprintf(stderr, "kernel_launch: hipFuncSetAttribute failed\n"); grid = -1; return; }
        if (hipOccupancyMaxActiveBlocksPerMultiprocessor(&per_cu, (const void*)trunk_fwd, NTHREADS, LDS_BYTES) != hipSuccess || per_cu < 1) { fprintf(stderr, "kernel_launch: occupancy query reports %d workgroups per CU; nothing launched\n", per_cu); (void)hipGetLastError(); grid = -1; return; }
        grid = cus;
    }
    if (grid < 0) return;
    if (hipMemsetAsync((char*)d_ws + WS_CTL, 0, CTL_ZERO_BYTES, stream) != hipSuccess) { fprintf(stderr, "kernel_launch: hipMemsetAsync failed\n"); return; }
    Args a{};
    for (int i = 0; i < 36; ++i) a.in[i] = d_in[i];
    a.out = (float*)d_out; a.ws = (unsigned char*)d_ws;
#if MK_MULTI
    for (int p = 0; p < N_PHASES; ++p) { a.ph_lo = p; a.ph_hi = p + 1; hipLaunchKernelGGL(trunk_fwd, dim3(grid), dim3(NTHREADS), LDS_BYTES, stream, a); }
#else
    a.ph_lo = 0; a.ph_hi = MK_PROBE ? 1000 : N_PHASES; hipLaunchKernelGGL(trunk_fwd, dim3(grid), dim3(NTHREADS), LDS_BYTES, stream, a);
#endif
    const hipError_t le = hipPeekAtLastError();
    if (le != hipSuccess) fprintf(stderr, "kernel_launch: launch failed: %s\n", hipGetErrorName(le));
}
```
